# Optimizing an MI355X kernel written in HIP

```python
import jax, jax.numpy as jnp
from jax import lax
import numpy as np

D_MODEL = 2048
BATCH = 16
SEQ = 2048
DEPTH = 1

CHUNK = 64
N_MEM = 256
FOX_HEADS = 16
FOX_HEAD_DIM = 128
FOX_WIDTH = FOX_HEADS * FOX_HEAD_DIM
CONV_WIDTH = 2048
CONV_TAPS = 3
MEM_HEADS = 4
MEM_HEAD_DIM = 128
MEM_WIDTH = MEM_HEADS * MEM_HEAD_DIM
D_FF = 5632
Q_BLOCK = 128
N_BRANCH = 2
EPS = 1e-6
FORGET_BIAS_INIT = 3.0
W_IN_COLS = 3 * FOX_WIDTH + FOX_HEADS + 3 * CONV_WIDTH + N_BRANCH * D_MODEL

kernel_name = "hybrid_fox_shortconv_macaron_sandwich"


def rmsnorm(x, g):
    xf = x.astype(jnp.float32)
    xf = xf * lax.rsqrt(jnp.mean(xf * xf, axis=-1, keepdims=True) + EPS)
    return (xf * g.astype(jnp.float32)).astype(x.dtype)


def swiglu(u, w13, w2):
    gate, up = jnp.split(u @ w13, 2, axis=-1)
    return (jax.nn.silu(gate) * up) @ w2


def forgetting_attention(q, k, v, log_f):
    b, s, h, dh = q.shape
    nb = s // Q_BLOCK
    scale = dh ** -0.5
    c = jnp.cumsum(log_f, axis=1).transpose(0, 2, 1)
    kh = k.transpose(0, 2, 1, 3)
    vh = v.transpose(0, 2, 1, 3)
    q_blocks = q.transpose(0, 2, 1, 3).reshape(b, h, nb, Q_BLOCK, dh).transpose(2, 0, 1, 3, 4)
    cq_blocks = c.reshape(b, h, nb, Q_BLOCK).transpose(2, 0, 1, 3)
    kpos = jnp.arange(s)

    def one_block(args):
        qb, cqb, i = args
        qpos = i * Q_BLOCK + jnp.arange(Q_BLOCK)
        logits = jnp.einsum('bhqd,bhkd->bhqk', qb, kh,
                            preferred_element_type=jnp.float32) * scale
        logits = logits + (cqb[..., :, None] - c[:, :, None, :])
        logits = jnp.where(kpos[None, :] <= qpos[:, None], logits, -jnp.inf)
        p = jax.nn.softmax(logits, axis=-1)
        return jnp.einsum('bhqk,bhkd->bhqd', p.astype(vh.dtype), vh)

    out = lax.map(one_block, (q_blocks, cq_blocks, jnp.arange(nb)))
    return out.transpose(1, 0, 3, 2, 4).reshape(b, s, h * dh)


def short_conv(z, w, bias):
    s = z.shape[1]
    zp = jnp.pad(z, ((0, 0), (CONV_TAPS - 1, 0), (0, 0)))
    y = bias
    for tap in range(CONV_TAPS):
        y = y + w[tap] * zp[:, tap:tap + s]
    return y


def memory_attention(u, mem_n, w_mq, w_mkv, w_mo):
    b, s, _ = u.shape
    m = mem_n.shape[1]
    q = (u @ w_mq).reshape(b, s, MEM_HEADS, MEM_HEAD_DIM)
    k, v = jnp.split(mem_n @ w_mkv, 2, axis=-1)
    k = k.reshape(b, m, MEM_HEADS, MEM_HEAD_DIM)
    v = v.reshape(b, m, MEM_HEADS, MEM_HEAD_DIM)
    logits = jnp.einsum('bshd,bmhd->bhsm', q, k,
                        preferred_element_type=jnp.float32) * (MEM_HEAD_DIM ** -0.5)
    p = jax.nn.softmax(logits, axis=-1)
    o = jnp.einsum('bhsm,bmhd->bshd', p.astype(v.dtype), v).reshape(b, s, MEM_WIDTH)
    return o @ w_mo


def setup_inputs(seed: int = 0) -> dict:
    key = jax.random.key(seed)
    ks = jax.random.split(key, 32)
    f32 = jnp.float32

    def w(k, shape, fan_in):
        return jax.random.normal(k, shape, f32) * (fan_in ** -0.5)

    def gain(k, shape):
        return 1.0 + 0.05 * jax.random.normal(k, shape, f32)

    L, D = DEPTH, D_MODEL
    return {
        "x": jax.random.normal(ks[0], (BATCH, SEQ, D), f32),
        "mem": jax.random.normal(ks[1], (BATCH, N_MEM, D), f32),
        "ffn1_pre_g": gain(ks[2], (L, D)),
        "ffn1_w13": w(ks[3], (L, D, 2 * D_FF), D),
        "ffn1_w2": w(ks[4], (L, D_FF, D), D_FF),
        "ffn1_post_g": gain(ks[5], (L, D)),
        "mix_pre_g": gain(ks[6], (L, D)),
        "w_in": w(ks[7], (L, D, W_IN_COLS), D),
        "forget_bias": FORGET_BIAS_INIT + 0.1 * jax.random.normal(ks[8], (L, FOX_HEADS), f32),
        "gate_bias": 0.02 * jax.random.normal(ks[9], (L, N_BRANCH, D), f32),
        "conv_w": w(ks[10], (L, CONV_TAPS, CONV_WIDTH), CONV_TAPS),
        "conv_b": 0.02 * jax.random.normal(ks[11], (L, CONV_WIDTH), f32),
        "w_out": w(ks[12], (L, D, D), D),
        "mix_post_g": gain(ks[13], (L, D)),
        "mem_q_pre_g": gain(ks[14], (L, D)),
        "mem_kv_g": gain(ks[15], (L, D)),
        "w_mq": w(ks[16], (L, D, MEM_WIDTH), D),
        "w_mkv": w(ks[17], (L, D, 2 * MEM_WIDTH), D),
        "w_mo": w(ks[18], (L, MEM_WIDTH, D), MEM_WIDTH),
        "mem_post_g": gain(ks[19], (L, D)),
        "ffn2_pre_g": gain(ks[20], (L, D)),
        "ffn2_w13": w(ks[21], (L, D, 2 * D_FF), D),
        "ffn2_w2": w(ks[22], (L, D_FF, D), D_FF),
        "ffn2_post_g": gain(ks[23], (L, D)),
    }


def reference(x, mem, ffn1_pre_g, ffn1_w13, ffn1_w2, ffn1_post_g, mix_pre_g, w_in,
              forget_bias, gate_bias, conv_w, conv_b, w_out, mix_post_g, mem_q_pre_g,
              mem_kv_g, w_mq, w_mkv, w_mo, mem_post_g, ffn2_pre_g, ffn2_w13, ffn2_w2,
              ffn2_post_g):
    b, s, _ = x.shape
    split_at = list(np.cumsum([FOX_WIDTH, FOX_WIDTH, FOX_WIDTH, FOX_HEADS,
                               CONV_WIDTH, CONV_WIDTH, CONV_WIDTH, D_MODEL]))
    h = x
    for l in range(DEPTH):
        f = swiglu(rmsnorm(h, ffn1_pre_g[l]), ffn1_w13[l], ffn1_w2[l])
        h = h + 0.5 * rmsnorm(f, ffn1_post_g[l])

        u = rmsnorm(h, mix_pre_g[l])
        p = u @ w_in[l]
        q, k, v, f_logit, cx, cb, cc, ga, gb = jnp.split(p, split_at, axis=-1)
        log_f = jax.nn.log_sigmoid((f_logit + forget_bias[l]).astype(jnp.float32))
        y_attn = forgetting_attention(q.reshape(b, s, FOX_HEADS, FOX_HEAD_DIM),
                                      k.reshape(b, s, FOX_HEADS, FOX_HEAD_DIM),
                                      v.reshape(b, s, FOX_HEADS, FOX_HEAD_DIM), log_f)
        y_conv = cb * short_conv(cc * cx, conv_w[l], conv_b[l])
        merged = (jax.nn.sigmoid(ga + gate_bias[l, 0]) * y_attn
                  + jax.nn.sigmoid(gb + gate_bias[l, 1]) * y_conv)
        h = h + rmsnorm(merged @ w_out[l], mix_post_g[l])

        m_out = memory_attention(rmsnorm(h, mem_q_pre_g[l]), rmsnorm(mem, mem_kv_g[l]),
                                 w_mq[l], w_mkv[l], w_mo[l])
        h = h + rmsnorm(m_out, mem_post_g[l])

        f = swiglu(rmsnorm(h, ffn2_pre_g[l]), ffn2_w13[l], ffn2_w2[l])
        h = h + 0.5 * rmsnorm(f, ffn2_post_g[l])
    return h
```

```cpp
#include <hip/hip_runtime.h>
#include <hip/hip_bf16.h>
#include <hip/hip_cooperative_groups.h>
#include <cstdio>
#include <cstdint>
namespace cg = cooperative_groups;

#ifndef LAST_PHASE
#define LAST_PHASE 11
#endif

#define LAS __attribute__((address_space(3)))
typedef unsigned short bf16_t;
typedef short bf16x8 __attribute__((ext_vector_type(8)));
typedef short s16x4 __attribute__((ext_vector_type(4)));
typedef float f32x4 __attribute__((ext_vector_type(4)));
typedef float f32x16 __attribute__((ext_vector_type(16)));
typedef unsigned u32x4 __attribute__((ext_vector_type(4)));
typedef unsigned u32x2 __attribute__((ext_vector_type(2)));

constexpr int BATCH = 16, SEQ = 2048, DM = 2048, M = BATCH * SEQ, NMEM = 256, MMEM = BATCH * NMEM, DFF = 5632;
constexpr int NH = 16, MH = 4, MW = 512;
constexpr int WIN_COLS = 16400, NIN = 65 * 256;
constexpr int CX0 = 6160, CB0 = 8208, CC0 = 10256, GA0 = 12304, GB0 = 14352, FL0 = 6144;
constexpr float EPS = 1e-6f;
constexpr float LOG2E = 1.4426950408889634f;

constexpr size_t MiB = 1u << 20;
constexpr size_t WS_X0 = 0;
constexpr size_t WS_BIG = 128 * MiB;
constexpr size_t WS_HID = WS_BIG;
constexpr size_t WS_W13A = WS_BIG + 352 * MiB;
constexpr size_t WS_W2A = WS_BIG + 396 * MiB;
constexpr size_t WS_QM = WS_BIG + 418 * MiB;
constexpr size_t WS_OM = WS_BIG + 450 * MiB;
constexpr size_t WS_QH = WS_BIG, WS_KH = WS_BIG + 128 * MiB, WS_VH = WS_BIG + 256 * MiB;
constexpr size_t WS_Z = WS_BIG + 384 * MiB, WS_WC = WS_BIG + 512 * MiB, WS_SA = WS_BIG + 640 * MiB;
constexpr size_t WS_X1 = WS_BIG + 512 * MiB;
constexpr size_t WS_WIN = 832 * MiB;
constexpr size_t WS_WOUT = 897 * MiB, WS_WMQ = 905 * MiB, WS_WMKV = 907 * MiB, WS_WMO = 911 * MiB;
constexpr size_t WS_W13B = 913 * MiB, WS_W2B = 957 * MiB;
constexpr size_t WS_MEMN = 979 * MiB;
constexpr size_t WS_KM = 995 * MiB, WS_VM = 999 * MiB;
constexpr size_t WS_SS = 1003 * MiB;
constexpr size_t WS_LOGF = 1007 * MiB;
constexpr size_t WS_KB = 1009 * MiB;
constexpr size_t WS_CTL = 1011 * MiB, CTL_ZERO_BYTES = 131072;
constexpr size_t WS_NRM = 1012 * MiB;
constexpr size_t WS_END = 1020 * MiB;
constexpr int CW_JLO = 12288;
constexpr int CW_PANEL = 16384;
constexpr int CW_RANK = 8192;

__device__ __forceinline__ unsigned cvt_pk_bf16(float lo, float hi) { unsigned r; asm volatile("v_cvt_pk_bf16_f32 %0, %1, %2" : "=v"(r) : "v"(lo), "v"(hi)); return r; }
__device__ __forceinline__ float bf_lo(unsigned w) { return __uint_as_float(w << 16); }
__device__ __forceinline__ float bf_hi(unsigned w) { return __uint_as_float(w & 0xffff0000u); }
__device__ __forceinline__ float bf1(bf16_t w) { return __uint_as_float(((unsigned)w) << 16); }
__device__ __forceinline__ float sigmoidf_(float x) { return __builtin_amdgcn_rcpf(1.0f + __builtin_amdgcn_exp2f(-x * LOG2E)); }
__device__ __forceinline__ void st_nt(u32x4* p, u32x4 v) { __builtin_nontemporal_store(v, p); }
__device__ __forceinline__ void st_nt2(u32x2* p, u32x2 v) { __builtin_nontemporal_store(v, p); }
__device__ __forceinline__ u32x4 pack8u(f32x4 a, f32x4 b) { u32x4 w; w.x = cvt_pk_bf16(a[0], a[1]); w.y = cvt_pk_bf16(a[2], a[3]); w.z = cvt_pk_bf16(b[0], b[1]); w.w = cvt_pk_bf16(b[2], b[3]); return w; }


__device__ __forceinline__ float wave_sum(float v) {
#pragma unroll
    for (int o = 1; o < 64; o <<= 1) v += __shfl_xor(v, o);
    return v;
}
struct RowArgs { const float* hin32; const bf16_t* hin16; bf16_t* hout16; float* outf; const float* gpost; const float* gpre; bf16_t* U; float alpha; };
__device__ __forceinline__ void row_one(const RowArgs& R, const bf16_t* F, const float* ss, int row, int lane) {
    f32x4 v[8];
    if (R.hin32) { const f32x4* xr = (const f32x4*)(R.hin32 + (size_t)row * DM) + lane;
#pragma unroll
        for (int j = 0; j < 8; ++j) v[j] = xr[64 * j]; }
    else { const u32x2* hr = (const u32x2*)(R.hin16 + (size_t)row * DM) + lane;
#pragma unroll
        for (int j = 0; j < 8; ++j) { const u32x2 w = hr[64 * j]; v[j][0] = bf_lo(w.x); v[j][1] = bf_hi(w.x); v[j][2] = bf_lo(w.y); v[j][3] = bf_hi(w.y); } }
    if (F) {
        float s = ss[(size_t)row * 32 + (lane & 31)];
#pragma unroll
        for (int o = 1; o < 32; o <<= 1) s += __shfl_xor(s, o);
        const float rs = rsqrtf(s * (1.0f / DM) + EPS) * R.alpha;
        const u32x2* fr = (const u32x2*)(F + (size_t)row * DM) + lane;
#pragma unroll
        for (int j = 0; j < 8; ++j) { const u32x2 w = fr[64 * j]; const f32x4 gp = ((const f32x4*)R.gpost)[lane + 64 * j];
            v[j][0] += bf_lo(w.x) * rs * gp[0]; v[j][1] += bf_hi(w.x) * rs * gp[1]; v[j][2] += bf_lo(w.y) * rs * gp[2]; v[j][3] += bf_hi(w.y) * rs * gp[3]; }
        if (R.outf) { f32x4* ho = (f32x4*)(R.outf + (size_t)row * DM) + lane;
#pragma unroll
            for (int j = 0; j < 8; ++j) ho[64 * j] = v[j]; }
        else { u32x2* ho = (u32x2*)(R.hout16 + (size_t)row * DM) + lane;
#pragma unroll
            for (int j = 0; j < 8; ++j) { u32x2 w; w.x = cvt_pk_bf16(v[j][0], v[j][1]); w.y = cvt_pk_bf16(v[j][2], v[j][3]); ho[64 * j] = w; } }
    }
    if (R.U) {
        float q = 0.f;
#pragma unroll
        for (int j = 0; j < 8; ++j) q += (v[j][0] * v[j][0] + v[j][1] * v[j][1]) + (v[j][2] * v[j][2] + v[j][3] * v[j][3]);
        q = wave_sum(q);
        const float r2 = rsqrtf(q * (1.0f / DM) + EPS);
        u32x2* uo = (u32x2*)(R.U + (size_t)row * DM) + lane;
#pragma unroll
        for (int j = 0; j < 8; ++j) { const f32x4 g = ((const f32x4*)R.gpre)[lane + 64 * j]; u32x2 w;
            w.x = cvt_pk_bf16(v[j][0] * r2 * g[0], v[j][1] * r2 * g[1]); w.y = cvt_pk_bf16(v[j][2] * r2 * g[2], v[j][3] * r2 * g[3]); uo[64 * j] = w; }
    }
}

template <int NR>
__device__ __forceinline__ void row_n(const RowArgs& R, const bf16_t* F, const float* ss, int row0, int stride, int lane) {
    f32x4 v[NR][8]; u32x2 fw[NR][8]; float s[NR];
#pragma unroll
    for (int n = 0; n < NR; ++n) { const int row = row0 + n * stride;
        s[n] = ss[(size_t)row * 32 + (lane & 31)];
        if (R.hin32) { const f32x4* xr = (const f32x4*)(R.hin32 + (size_t)row * DM) + lane;
#pragma unroll
            for (int j = 0; j < 8; ++j) v[n][j] = xr[64 * j]; }
        else { const u32x2* hr = (const u32x2*)(R.hin16 + (size_t)row * DM) + lane;
#pragma unroll
            for (int j = 0; j < 8; ++j) { const u32x2 w = hr[64 * j]; v[n][j][0] = bf_lo(w.x); v[n][j][1] = bf_hi(w.x); v[n][j][2] = bf_lo(w.y); v[n][j][3] = bf_hi(w.y); } }
        const u32x2* fr = (const u32x2*)(F + (size_t)row * DM) + lane;
#pragma unroll
        for (int j = 0; j < 8; ++j) fw[n][j] = fr[64 * j]; }
#pragma unroll
    for (int n = 0; n < NR; ++n) {
#pragma unroll
        for (int o = 1; o < 32; o <<= 1) s[n] += __shfl_xor(s[n], o);
        s[n] = rsqrtf(s[n] * (1.0f / DM) + EPS) * R.alpha; }
#pragma unroll
    for (int j = 0; j < 8; ++j) { const f32x4 gp = ((const f32x4*)R.gpost)[lane + 64 * j];
#pragma unroll
        for (int n = 0; n < NR; ++n) { const u32x2 w = fw[n][j]; const float rs = s[n];
            v[n][j][0] += bf_lo(w.x) * rs * gp[0]; v[n][j][1] += bf_hi(w.x) * rs * gp[1]; v[n][j][2] += bf_lo(w.y) * rs * gp[2]; v[n][j][3] += bf_hi(w.y) * rs * gp[3]; } }
#pragma unroll
    for (int n = 0; n < NR; ++n) { const int row = row0 + n * stride;
        if (R.outf) { f32x4* ho = (f32x4*)(R.outf + (size_t)row * DM) + lane;
#pragma unroll
            for (int j = 0; j < 8; ++j) ho[64 * j] = v[n][j]; }
        else { u32x2* ho = (u32x2*)(R.hout16 + (size_t)row * DM) + lane;
#pragma unroll
            for (int j = 0; j < 8; ++j) { u32x2 w; w.x = cvt_pk_bf16(v[n][j][0], v[n][j][1]); w.y = cvt_pk_bf16(v[n][j][2], v[n][j][3]); ho[64 * j] = w; } } }
    if (R.U) {
        float q[NR];
#pragma unroll
        for (int n = 0; n < NR; ++n) { q[n] = 0.f;
#pragma unroll
            for (int j = 0; j < 8; ++j) q[n] += (v[n][j][0] * v[n][j][0] + v[n][j][1] * v[n][j][1]) + (v[n][j][2] * v[n][j][2] + v[n][j][3] * v[n][j][3]);
            q[n] = rsqrtf(wave_sum(q[n]) * (1.0f / DM) + EPS); }
#pragma unroll
        for (int j = 0; j < 8; ++j) { const f32x4 g = ((const f32x4*)R.gpre)[lane + 64 * j];
#pragma unroll
            for (int n = 0; n < NR; ++n) { u32x2 w; const float r2 = q[n];
                w.x = cvt_pk_bf16(v[n][j][0] * r2 * g[0], v[n][j][1] * r2 * g[1]); w.y = cvt_pk_bf16(v[n][j][2] * r2 * g[2], v[n][j][3] * r2 * g[3]);
                ((u32x2*)(R.U + (size_t)(row0 + n * stride) * DM) + lane)[64 * j] = w; } }
    }
}

template <int NR>
__device__ __forceinline__ void rowU_n(const float* hin32, const float* gpre, bf16_t* U, int row0, int stride, int lane) {
    f32x4 v[NR][8]; float q[NR];
#pragma unroll
    for (int n = 0; n < NR; ++n) { const f32x4* xr = (const f32x4*)(hin32 + (size_t)(row0 + n * stride) * DM) + lane;
#pragma unroll
        for (int j = 0; j < 8; ++j) v[n][j] = xr[64 * j]; }
#pragma unroll
    for (int n = 0; n < NR; ++n) { q[n] = 0.f;
#pragma unroll
        for (int j = 0; j < 8; ++j) q[n] += (v[n][j][0] * v[n][j][0] + v[n][j][1] * v[n][j][1]) + (v[n][j][2] * v[n][j][2] + v[n][j][3] * v[n][j][3]);
        q[n] = rsqrtf(wave_sum(q[n]) * (1.0f / DM) + EPS); }
#pragma unroll
    for (int j = 0; j < 8; ++j) { const f32x4 g = ((const f32x4*)gpre)[lane + 64 * j];
#pragma unroll
        for (int n = 0; n < NR; ++n) { u32x2 w; const float r2 = q[n];
            w.x = cvt_pk_bf16(v[n][j][0] * r2 * g[0], v[n][j][1] * r2 * g[1]); w.y = cvt_pk_bf16(v[n][j][2] * r2 * g[2], v[n][j][3] * r2 * g[3]);
            ((u32x2*)(U + (size_t)(row0 + n * stride) * DM) + lane)[64 * j] = w; } }
}

namespace pg8 {
constexpr int BM = 256, BK = 64, HALF = 128, HTB = HALF * BK * 2, STAGE_BYTES = 8 * HTB, NXCD = 8, WGM = 4;
__host__ __device__ __forceinline__ int lds_byte(int r, int c) { const int st = (r >> 4) * 2 + (c >> 5), rr = r & 15, cc = c & 31, ob = rr * 64 + cc * 2; return st * 1024 + (ob ^ (((ob >> 9) & 1) << 5)); }
__host__ __device__ __forceinline__ void stage_rc(int b, int& R, int& C) { const int st = b / 1024, sb = b % 1024, swz = sb ^ (((sb >> 9) & 1) << 5); R = (st >> 1) * 16 + swz / 64; C = (st & 1) * 32 + (swz % 64) / 2; }
__host__ __device__ __forceinline__ int perm32(int rho) { const int n = rho >> 4, i = rho & 15; return 8 * (i >> 2) + 4 * n + (i & 3); }
struct Unit { int pm, pn; };
struct Gemm { const bf16_t* A; const bf16_t* Bt; int M, N, K; };
struct StaticOrder {
    int nN, mt, nun, x, rank, nloc;
    __device__ void init(int M_, int N_, int nx_, int nloc_, int x_, int rank_) { nN = N_ / BM; mt = (M_ / BM) / nx_; nun = mt * nN; x = x_; rank = rank_; nloc = nloc_; }
    __device__ bool next(int i, Unit& u) const {
        const int off = i * nloc + rank; if (off >= nun) return false;
        const int nig = WGM * nN, gid = off / nig, fm = gid * WGM, gsz = (mt - fm) < WGM ? (mt - fm) : WGM;
        u.pm = x * mt + fm + ((off % nig) % gsz); u.pn = (off % nig) / gsz; return true;
    }
};
typedef f32x4 Acc[2][2][4][2];

struct EpiSwiGLU {
    static constexpr bool FUSED = false;
    bf16_t* H;
    __device__ __forceinline__ void operator()(const Acc& acc, const Unit& u, int wr, int wc, int fr, int fq) const {
        const int row0 = u.pm * BM + wr * 64 + fr; const int col0 = u.pn * 128 + wc * 32 + 8 * fq;
#pragma unroll
        for (int ai = 0; ai < 2; ++ai)
#pragma unroll
            for (int m = 0; m < 4; ++m) {
                f32x4 h[2];
#pragma unroll
                for (int n = 0; n < 2; ++n)
#pragma unroll
                    for (int j = 0; j < 4; ++j) { const float g = acc[ai][0][m][n][j]; h[n][j] = g * sigmoidf_(g) * acc[ai][1][m][n][j]; }
                st_nt((u32x4*)(H + (size_t)(row0 + ai * HALF + m * 16) * DFF + col0), pack8u(h[0], h[1]));
            }
    }
};
struct EpiRowSS {
    static constexpr bool FUSED = true;
    bf16_t* F; float* ss; RowArgs R; unsigned* cnt; unsigned target;
    __device__ __forceinline__ void operator()(const Acc& acc, const Unit& u, int wr, int wc, int fr, int fq) const {
        const int row0 = u.pm * BM + wr * 64 + fr; const int col0 = u.pn * BM + wc * 32 + 8 * fq;
#pragma unroll
        for (int ai = 0; ai < 2; ++ai)
#pragma unroll
            for (int m = 0; m < 4; ++m) {
                const int row = row0 + ai * HALF + m * 16; float s = 0.f;
#pragma unroll
                for (int bj = 0; bj < 2; ++bj) { const f32x4 a = acc[ai][bj][m][0], b = acc[ai][bj][m][1];
                    s += (a[0] * a[0] + a[1] * a[1]) + (a[2] * a[2] + a[3] * a[3]) + (b[0] * b[0] + b[1] * b[1]) + (b[2] * b[2] + b[3] * b[3]);
                    *(u32x4*)(F + (size_t)row * DM + col0 + bj * HALF) = pack8u(a, b); }
                s += __shfl_xor(s, 16); s += __shfl_xor(s, 32);
                if (fq == 0) ss[(size_t)row * 32 + u.pn * 4 + wc] = s;
            }
    }
};
struct EpiHeads {
    static constexpr bool FUSED = false;
    bf16_t* O; size_t tstride; int nh_shift; int s_shift;
    __device__ __forceinline__ void operator()(const Acc& acc, const Unit& u, int wr, int wc, int fr, int fq) const {
        const int row0 = u.pm * BM + wr * 64 + fr; const int cw = wc * 32 + 8 * fq;
#pragma unroll
        for (int bj = 0; bj < 2; ++bj) { const int hidx = u.pn * 2 + bj, t = hidx >> nh_shift, head = hidx & ((1 << nh_shift) - 1);
            bf16_t* base = O + (size_t)t * tstride;
#pragma unroll
            for (int ai = 0; ai < 2; ++ai)
#pragma unroll
                for (int m = 0; m < 4; ++m) { const int row = row0 + ai * HALF + m * 16, b = row >> s_shift, s = row & ((1 << s_shift) - 1);
                    *(u32x4*)(base + ((((size_t)b << nh_shift) + head) << s_shift) * 128 + (size_t)s * 128 + cw) = pack8u(acc[ai][bj][m][0], acc[ai][bj][m][1]); } }
    }
};
struct EpiIn {
    static constexpr bool FUSED = false;
    bf16_t* QKV; size_t tstride; bf16_t* Z; bf16_t* WC; unsigned char* SA; float* LOGF; const float* gate_bias; const float* forget_bias; bf16_t* NRM;
    __device__ __forceinline__ void operator()(const Acc& acc, const Unit& u, int wr, int wc, int fr, int fq) const {
        const int pn = u.pn; const int row0 = u.pm * BM + wr * 64 + fr; const int cw = wc * 32 + 8 * fq;
        if (pn < 24) {
#pragma unroll
            for (int bj = 0; bj < 2; ++bj) { const int hidx = pn * 2 + bj, t = hidx >> 4, head = hidx & 15;
                bf16_t* base = QKV + (size_t)t * tstride;
#pragma unroll
                for (int ai = 0; ai < 2; ++ai)
#pragma unroll
                    for (int m = 0; m < 4; ++m) { const int row = row0 + ai * HALF + m * 16, b = row >> 11, s = row & 2047;
                        st_nt((u32x4*)(base + ((size_t)(b * 16 + head) * SEQ + s) * 128 + cw), pack8u(acc[ai][bj][m][0], acc[ai][bj][m][1]));
                        if (pn < 16) {
                            const f32x4 a = acc[ai][bj][m][0], c = acc[ai][bj][m][1];
                            float sq = (a[0] * a[0] + a[1] * a[1]) + (a[2] * a[2] + a[3] * a[3]) + (c[0] * c[0] + c[1] * c[1]) + (c[2] * c[2] + c[3] * c[3]);
                            sq += __shfl_xor(sq, 16); sq += __shfl_xor(sq, 32);
                            if (fq == 0) NRM[(size_t)t * ((size_t)M * 64) + ((size_t)row * 16 + head) * 4 + wc] = (bf16_t)(cvt_pk_bf16(sq * 1.02f, 0.f) & 0xffffu); } } }
        } else if (pn < 40) {
            const int cz = (pn - 24) * 128 + cw;
#pragma unroll
            for (int ai = 0; ai < 2; ++ai)
#pragma unroll
                for (int m = 0; m < 4; ++m) { const int row = row0 + ai * HALF + m * 16;
                    st_nt((u32x4*)(Z + (size_t)row * DM + cz), pack8u(acc[ai][0][m][0] * acc[ai][1][m][0], acc[ai][0][m][1] * acc[ai][1][m][1])); }
        } else if (pn < 56) {
            const int cz = (pn - 40) * 128 + cw;
            const f32x4 g0 = *(const f32x4*)(gate_bias + DM + cz), g1 = *(const f32x4*)(gate_bias + DM + cz + 4);
#pragma unroll
            for (int ai = 0; ai < 2; ++ai)
#pragma unroll
                for (int m = 0; m < 4; ++m) { const int row = row0 + ai * HALF + m * 16; f32x4 w0, w1;
#pragma unroll
                    for (int j = 0; j < 4; ++j) { w0[j] = acc[ai][0][m][0][j] * sigmoidf_(acc[ai][1][m][0][j] + g0[j]); w1[j] = acc[ai][0][m][1][j] * sigmoidf_(acc[ai][1][m][1][j] + g1[j]); }
                    st_nt((u32x4*)(WC + (size_t)row * DM + cz), pack8u(w0, w1)); }
        } else if (pn < 64) {
#pragma unroll
            for (int bj = 0; bj < 2; ++bj) { const int cz = (pn - 56) * 256 + bj * HALF + cw;
                const f32x4 g0 = *(const f32x4*)(gate_bias + cz), g1 = *(const f32x4*)(gate_bias + cz + 4);
#pragma unroll
                for (int ai = 0; ai < 2; ++ai)
#pragma unroll
                    for (int m = 0; m < 4; ++m) { const int row = row0 + ai * HALF + m * 16; unsigned q0 = 0u, q1 = 0u;
#pragma unroll
                        for (int j = 0; j < 4; ++j) { q0 |= ((unsigned)(sigmoidf_(acc[ai][bj][m][0][j] + g0[j]) * 255.f + 0.5f)) << (8 * j); q1 |= ((unsigned)(sigmoidf_(acc[ai][bj][m][1][j] + g1[j]) * 255.f + 0.5f)) << (8 * j); }
                        u32x2 w; w.x = q0; w.y = q1; st_nt2((u32x2*)(SA + (size_t)row * DM + cz), w); } }
        } else {
            if (wc == 0 && fq < 2) {
                const f32x4 fb0 = *(const f32x4*)(forget_bias + 8 * fq), fb1 = *(const f32x4*)(forget_bias + 8 * fq + 4);
#pragma unroll
                for (int ai = 0; ai < 2; ++ai)
#pragma unroll
                    for (int m = 0; m < 4; ++m) { const int row = row0 + ai * HALF + m * 16; f32x4 l0, l1;
#pragma unroll
                        for (int j = 0; j < 4; ++j) { const float x0 = acc[ai][0][m][0][j] + fb0[j], x1 = acc[ai][0][m][1][j] + fb1[j];
                            l0[j] = fminf(x0, 0.f) - log1pf(expf(-fabsf(x0))); l1[j] = fminf(x1, 0.f) - log1pf(expf(-fabsf(x1))); }
                        *(f32x4*)(LOGF + (size_t)row * 16 + 8 * fq) = l0; *(f32x4*)(LOGF + (size_t)row * 16 + 8 * fq + 4) = l1; }
            }
        }
    }
};

template <class Epi>
__device__ __forceinline__ void gemm_phase(LAS unsigned char* lds, const Gemm g, const StaticOrder& S, const Epi& E, const int tid) {
    const int wid = __builtin_amdgcn_readfirstlane(tid >> 6), lane = tid & 63, wr = wid >> 2, wc = wid & 3, fr = lane & 15, fq = lane >> 4;
    const int K = g.K, nt = K / BK;
    unsigned voffA[2], voffB[2];
#pragma unroll
    for (int i = 0; i < 2; ++i) { int R, C; stage_rc(tid * 16 + i * 8192, R, C); const int Rb = (R & ~31) + perm32(R & 31);
        voffA[i] = (unsigned)(R * K + C) * 2u; voffB[i] = (unsigned)(Rb * K + C) * 2u; }
    const size_t kstep = (size_t)(BK * 2);
    const size_t hstep = (size_t)HALF * K * 2;
    const size_t tstep = 2 * hstep;
    const unsigned ldsw = (unsigned)wid * 1024u;
    const int aoff = lds_byte(wr * 64 + fr, fq * 8), boff = lds_byte(wc * 32 + fr, fq * 8);
#define PG8_SA(b, h) (((b) * 2 + (h)) * HTB)
#define PG8_SB(b, h) ((4 + (b) * 2 + (h)) * HTB)
#define PG8_STAGE(bufoff, gbase, voff) do { _Pragma("unroll") for (int _i = 0; _i < 2; ++_i) \
        __builtin_amdgcn_global_load_lds((const unsigned*)((const char*)(gbase) + (voff)[_i]), (LAS unsigned*)(lds + (bufoff) + ldsw + _i * 8192), 16, 0, 0); } while (0)
#define PG8_LDA(dst, b, h) do { _Pragma("unroll") for (int m = 0; m < 4; ++m) _Pragma("unroll") for (int k = 0; k < 2; ++k) dst[m][k] = *(const LAS bf16x8*)(lds + PG8_SA(b, h) + aoff + m * 2048 + k * 1024); } while (0)
#define PG8_LDB(dst, b, h) do { _Pragma("unroll") for (int n = 0; n < 2; ++n) _Pragma("unroll") for (int k = 0; k < 2; ++k) dst[n][k] = *(const LAS bf16x8*)(lds + PG8_SB(b, h) + boff + n * 2048 + k * 1024); } while (0)
#define PG8_MMA(ai, bj, At, Bt) do { __builtin_amdgcn_s_setprio(1); _Pragma("unroll") for (int m = 0; m < 4; ++m) _Pragma("unroll") for (int n = 0; n < 2; ++n) _Pragma("unroll") for (int k = 0; k < 2; ++k) \
        acc[ai][bj][m][n] = __builtin_amdgcn_mfma_f32_16x16x32_bf16(Bt[n][k], At[m][k], acc[ai][bj][m][n], 0, 0, 0); __builtin_amdgcn_s_setprio(0); } while (0)
#define PG8_WAIT_V(n) asm volatile("s_waitcnt vmcnt(" #n ")" ::: "memory")
#define PG8_WAIT_L(n) asm volatile("s_waitcnt lgkmcnt(" #n ")" ::: "memory")
#define PG8_BAR __builtin_amdgcn_s_barrier()
#define PG8_SCHED __builtin_amdgcn_sched_barrier(0)
    Unit cur, nxt; int ui = 0;
    if (!S.next(0, cur)) return;
    Unit prev = cur; bool have_prev = false;
    f32x4 acc[2][2][4][2];
#pragma unroll
    for (int a = 0; a < 2; ++a)
#pragma unroll
        for (int b = 0; b < 2; ++b)
#pragma unroll
            for (int m = 0; m < 4; ++m)
#pragma unroll
                for (int n = 0; n < 2; ++n) acc[a][b][m][n] = (f32x4){0.f, 0.f, 0.f, 0.f};
    bf16x8 At[4][2], B0[2][2], B1[2][2];
    const char* cA = (const char*)g.A + (size_t)cur.pm * tstep; const char* cB = (const char*)g.Bt + (size_t)cur.pn * tstep;
    PG8_STAGE(PG8_SB(0, 0), cB, voffB); PG8_STAGE(PG8_SB(0, 1), cB + hstep, voffB); PG8_STAGE(PG8_SA(0, 0), cA, voffA); PG8_STAGE(PG8_SA(0, 1), cA + hstep, voffA);
    if (wr == 1) PG8_BAR;
    PG8_WAIT_V(2); PG8_BAR;
    PG8_STAGE(PG8_SB(1, 0), cB + kstep, voffB); PG8_STAGE(PG8_SA(1, 0), cA + kstep, voffA); PG8_STAGE(PG8_SB(1, 1), cB + hstep + kstep, voffB);
    PG8_WAIT_V(6); PG8_BAR;
    for (;;) {
        const bool has_next = S.next(ui + 1, nxt);
        const char* nA = has_next ? (const char*)g.A + (size_t)nxt.pm * tstep : cA; const char* nB = has_next ? (const char*)g.Bt + (size_t)nxt.pn * tstep : cB;
        for (int t = 0; t < nt; t += 2) {
            const bool last = (t == nt - 2);
            const char* a1 = cA + (size_t)(t + 1) * kstep;
            const char* a2 = last ? nA : cA + (size_t)(t + 2) * kstep; const char* b2 = last ? nB : cB + (size_t)(t + 2) * kstep;
            const char* a3 = a2 + kstep; const char* b3 = b2 + kstep;
            PG8_LDB(B0, 0, 0); PG8_LDB(B1, 0, 1); PG8_SCHED; PG8_LDA(At, 0, 0); PG8_STAGE(PG8_SA(1, 1), a1 + hstep, voffA);
            PG8_WAIT_V(8); PG8_WAIT_L(0); PG8_BAR; PG8_MMA(0, 0, At, B0); PG8_MMA(0, 1, At, B1); PG8_BAR; PG8_SCHED;
            PG8_LDA(At, 0, 1); PG8_STAGE(PG8_SB(0, 0), b2, voffB); PG8_STAGE(PG8_SB(0, 1), b2 + hstep, voffB); PG8_STAGE(PG8_SA(0, 0), a2, voffA);
            PG8_WAIT_V(8); PG8_WAIT_L(0); PG8_BAR; PG8_MMA(1, 0, At, B0); PG8_MMA(1, 1, At, B1); PG8_BAR; PG8_SCHED;
            PG8_LDB(B0, 1, 0); PG8_LDB(B1, 1, 1); PG8_SCHED; PG8_LDA(At, 1, 0); PG8_STAGE(PG8_SA(0, 1), a2 + hstep, voffA);
            PG8_WAIT_V(8); PG8_WAIT_L(0); PG8_BAR; PG8_MMA(0, 0, At, B0); PG8_MMA(0, 1, At, B1); PG8_BAR; PG8_SCHED;
            PG8_LDA(At, 1, 1); PG8_STAGE(PG8_SB(1, 0), b3, voffB); PG8_STAGE(PG8_SB(1, 1), b3 + hstep, voffB); PG8_STAGE(PG8_SA(1, 0), a3, voffA);
            PG8_WAIT_V(8); PG8_WAIT_L(0); PG8_BAR; PG8_MMA(1, 0, At, B0); PG8_MMA(1, 1, At, B1); PG8_BAR; PG8_SCHED;
        }
        if (wr == 0) PG8_BAR;
        E(acc, cur, wr, wc, fr, fq);
        if constexpr (Epi::FUSED) {
            asm volatile("s_waitcnt vmcnt(0)" ::: "memory");
            __builtin_amdgcn_s_barrier();
            if (tid == 0) {
                __hip_atomic_fetch_add(E.cnt + 64 * cur.pm, 1u, __ATOMIC_RELAXED, __HIP_MEMORY_SCOPE_AGENT);
                if (have_prev) { unsigned* c = E.cnt + 64 * prev.pm; unsigned sp = 0;
                    while (__hip_atomic_load(c, __ATOMIC_RELAXED, __HIP_MEMORY_SCOPE_AGENT) < E.target) { __builtin_amdgcn_s_sleep(1); if (++sp > (1u << 22)) break; }
                    __builtin_amdgcn_fence(__ATOMIC_ACQUIRE, "agent");
                    asm volatile("s_waitcnt vmcnt(0)" ::: "memory"); }
            }
            __builtin_amdgcn_s_barrier();
            asm volatile("" ::: "memory");
            if (have_prev) {
                int lane_f = lane; asm volatile("" : "+v"(lane_f));
#pragma unroll 1
                for (int r = wid; r < 32; r += 16) row_n<2>(E.R, E.F, E.ss, prev.pm * BM + prev.pn * 32 + r, 8, lane_f);
                asm volatile("s_waitcnt vmcnt(0)" ::: "memory");
            }
            prev = cur; have_prev = true;
        }
        if (!has_next) break;
#pragma unroll
        for (int a = 0; a < 2; ++a)
#pragma unroll
            for (int b = 0; b < 2; ++b)
#pragma unroll
                for (int m = 0; m < 4; ++m)
#pragma unroll
                    for (int n = 0; n < 2; ++n) acc[a][b][m][n] = (f32x4){0.f, 0.f, 0.f, 0.f};
        cur = nxt; cA = nA; cB = nB; ++ui;
        if (wr == 1) PG8_BAR;
    }
    PG8_WAIT_V(0);
    PG8_BAR;
    if constexpr (Epi::FUSED) {
        if (have_prev) {
            if (tid == 0) { unsigned* c = E.cnt + 64 * prev.pm; unsigned sp = 0;
                while (__hip_atomic_load(c, __ATOMIC_RELAXED, __HIP_MEMORY_SCOPE_AGENT) < E.target) { __builtin_amdgcn_s_sleep(1); if (++sp > (1u << 22)) break; }
                __builtin_amdgcn_fence(__ATOMIC_ACQUIRE, "agent");
                asm volatile("s_waitcnt vmcnt(0)" ::: "memory"); }
            __builtin_amdgcn_s_barrier();
            asm volatile("" ::: "memory");
            int lane_f = lane; asm volatile("" : "+v"(lane_f));
#pragma unroll 1
            for (int r = wid; r < 32; r += 16) row_n<2>(E.R, E.F, E.ss, prev.pm * BM + prev.pn * 32 + r, 8, lane_f);
        }
    }
#undef PG8_SA
#undef PG8_SB
#undef PG8_STAGE
#undef PG8_LDA
#undef PG8_LDB
#undef PG8_MMA
#undef PG8_WAIT_V
#undef PG8_WAIT_L
#undef PG8_BAR
#undef PG8_SCHED
}
}

namespace fa {
constexpr int D = 128, NW = 8, QBLK = 32, KVBLK = 64, QB = NW * QBLK;
constexpr int SHM_V = KVBLK * D * 2, SHM_K = KVBLK * D * 2;
constexpr int OFF_WS = 2 * SHM_V + 2 * SHM_K, OFF_KB = OFF_WS + NW * 64 * 4, OFF_OST = OFF_KB + 2 * 2048 * 4, OST_ROW = 136, LDS_BYTES = OFF_OST + NW * 32 * OST_ROW * 2;
constexpr float SCALE = 0.08838834764831845f, C2 = LOG2E * SCALE, THR2 = 8.f;
#define KSWZ(row, colB) ((row) * 256 + ((colB) ^ (((row) & 7) << 4)))
#define SBAR() __builtin_amdgcn_sched_barrier(0)
__device__ __forceinline__ int v_st(int k, int c) { const int kk = (k & ~0xC) | ((k & 4) << 1) | ((k & 8) >> 1); return ((kk >> 3) * 4 + (c >> 5)) * 512 + ((kk & 7) * 32 + (c & 31)) * 2; }
__device__ __forceinline__ int v_rd_base(int lane) { return ((lane & 3) << 3) | (((lane >> 2) & 3) << 6) | (((lane >> 4) & 1) << 5) | (((lane >> 5) & 1) << 8); }
constexpr int v_rd_off(int d0, int ks, int half) { return d0 * 512 + ks * 4096 + half * 2048; }
__device__ __forceinline__ int crow(int r, int hi) { return (r & 3) + 8 * (r >> 2) + 4 * hi; }
__device__ __forceinline__ bf16x8 load8(const bf16_t* p) { return *reinterpret_cast<const bf16x8*>(p); }
__device__ __forceinline__ void mask_tile(f32x16& p0, f32x16& p1, int dq, unsigned W) {
    const float NEG = -__builtin_inff();
#pragma unroll
    for (int r = 0; r < 16; ++r) {
        const int c = (r & 3) + 8 * (r >> 2);
        if ((unsigned)(dq - c) >= W) p0[r] = NEG;
        if ((unsigned)(dq - c - 32) >= W) p1[r] = NEG;
    }
}
__device__ __forceinline__ void partialSM(f32x16& p0, f32x16& p1, const float* kb, float& m_reg, float& mn, float& alpha) {
#pragma unroll
    for (int g = 0; g < 4; ++g) { const f32x4 b0 = *(const f32x4*)(kb + 8 * g), b1 = *(const f32x4*)(kb + 32 + 8 * g);
#pragma unroll
        for (int j = 0; j < 4; ++j) { p0[4 * g + j] = fmaf(p0[4 * g + j], C2, b0[j]); p1[4 * g + j] = fmaf(p1[4 * g + j], C2, b1[j]); } }
    float pmax = p0[0];
#pragma unroll
    for (int r = 1; r < 16; ++r) pmax = fmaxf(pmax, p0[r]);
#pragma unroll
    for (int r = 0; r < 16; ++r) pmax = fmaxf(pmax, p1[r]);
    { auto rr = __builtin_amdgcn_permlane32_swap(__float_as_uint(pmax), __float_as_uint(pmax), false, false);
      pmax = fmaxf(__uint_as_float(rr[0]), __uint_as_float(rr[1])); }
    if (__builtin_expect(__all((pmax - m_reg) <= THR2), 1)) { mn = m_reg; alpha = 1.f; }
    else { mn = fmaxf(m_reg, pmax); alpha = __builtin_amdgcn_exp2f(m_reg - mn); m_reg = mn; }
#pragma unroll
    for (int r = 0; r < 16; ++r) { p0[r] -= mn; p1[r] -= mn; }
#pragma unroll
    for (int r = 0; r < 16; ++r) p0[r] = __builtin_amdgcn_exp2f(p0[r]);
}
__device__ __forceinline__ void finishSM(f32x16& p0, f32x16& p1, float alpha, float& l_reg, bf16x8& pa0, bf16x8& pa1, bf16x8& pa2, bf16x8& pa3) {
#pragma unroll
    for (int r = 0; r < 16; ++r) p1[r] = __builtin_amdgcn_exp2f(p1[r]);
    float ps = 0;
#pragma unroll
    for (int r = 0; r < 16; ++r) ps += p0[r];
#pragma unroll
    for (int r = 0; r < 16; ++r) ps += p1[r];
    { auto rr = __builtin_amdgcn_permlane32_swap(__float_as_uint(ps), __float_as_uint(ps), false, false);
      ps = __uint_as_float(rr[0]) + __uint_as_float(rr[1]); }
    l_reg = l_reg * alpha + ps;
#define PK4(P, B_, OUT) do { unsigned a0 = cvt_pk_bf16(P[B_+0], P[B_+1]), a1 = cvt_pk_bf16(P[B_+2], P[B_+3]);                          \
        unsigned b0 = cvt_pk_bf16(P[B_+4], P[B_+5]), b1 = cvt_pk_bf16(P[B_+6], P[B_+7]);                                             \
        auto r0 = __builtin_amdgcn_permlane32_swap(a0, b0, false, false); auto r1 = __builtin_amdgcn_permlane32_swap(a1, b1, false, false); \
        u32x4 w = {r0[0], r1[0], r0[1], r1[1]}; OUT = *reinterpret_cast<bf16x8*>(&w); } while (0)
    PK4(p0, 0, pa0); PK4(p0, 8, pa1); PK4(p1, 0, pa2); PK4(p1, 8, pa3);
#undef PK4
}
template <int KB>
__device__ __forceinline__ void qkt(f32x16& p0, f32x16& p1, const char* K_lds, int r32, int hi, const bf16x8* qr) {
    p0 = f32x16{}; p1 = f32x16{};
    const char* kb[4];
#pragma unroll
    for (int dd = 0; dd < 4; ++dd) kb[dd] = K_lds + KB * SHM_K + KSWZ(r32, (dd * 16 + hi * 8) * 2);
    __builtin_amdgcn_s_setprio(1);
#pragma unroll
    for (int d0 = 0; d0 < 8; ++d0) { const char* a = kb[d0 & 3] + (d0 >> 2) * 128;
        bf16x8 b0 = *reinterpret_cast<const bf16x8*>(a);
        bf16x8 b1 = *reinterpret_cast<const bf16x8*>(a + 32 * 256);
        p0 = __builtin_amdgcn_mfma_f32_32x32x16_bf16(b0, qr[d0], p0, 0, 0, 0);
        p1 = __builtin_amdgcn_mfma_f32_32x32x16_bf16(b1, qr[d0], p1, 0, 0, 0); }
    __builtin_amdgcn_s_setprio(0);
}
template <int VB>
__device__ __forceinline__ void pv_tile(f32x16* o, int vb0, bf16x8 pa0, bf16x8 pa1, bf16x8 pa2, bf16x8 pa3) {
#define TRRD(dst, off) asm volatile("ds_read_b64_tr_b16 %0, %1 offset:%2" : "=&v"(dst) : "v"(vb0), "i"(off) : "memory")
#define PV_D0(d0) do { s16x4 l0, l1, l2, l3, h0, h1, h2, h3; constexpr int b_ = VB * SHM_V + v_rd_off(d0, 0, 0); \
        TRRD(l0, b_); TRRD(h0, b_ + 2048); TRRD(l1, b_ + 4096); TRRD(h1, b_ + 6144); TRRD(l2, b_ + 8192); TRRD(h2, b_ + 10240); TRRD(l3, b_ + 12288); TRRD(h3, b_ + 14336); \
        asm volatile("s_waitcnt lgkmcnt(0)" ::: "memory"); SBAR();   \
        o[d0] = __builtin_amdgcn_mfma_f32_32x32x16_bf16(pa0, (bf16x8){l0[0], l0[1], l0[2], l0[3], h0[0], h0[1], h0[2], h0[3]}, o[d0], 0, 0, 0);   \
        o[d0] = __builtin_amdgcn_mfma_f32_32x32x16_bf16(pa1, (bf16x8){l1[0], l1[1], l1[2], l1[3], h1[0], h1[1], h1[2], h1[3]}, o[d0], 0, 0, 0);   \
        o[d0] = __builtin_amdgcn_mfma_f32_32x32x16_bf16(pa2, (bf16x8){l2[0], l2[1], l2[2], l2[3], h2[0], h2[1], h2[2], h2[3]}, o[d0], 0, 0, 0);   \
        o[d0] = __builtin_amdgcn_mfma_f32_32x32x16_bf16(pa3, (bf16x8){l3[0], l3[1], l3[2], l3[3], h3[0], h3[1], h3[2], h3[3]}, o[d0], 0, 0, 0); } while (0)
    __builtin_amdgcn_s_setprio(1);
    PV_D0(0); PV_D0(1); PV_D0(2); PV_D0(3);
    __builtin_amdgcn_s_setprio(0);
#undef PV_D0
#undef TRRD
}
struct Blk { const bf16_t* Q; const bf16_t* K; const bf16_t* V; const float* KBg; size_t ooff; int P0; int col0; int jlo; };
struct Phase { int mode; int skv; int W; int pitch; bf16_t* O; const unsigned char* SA; const bf16_t* WC; const bf16_t* Z; const float* conv_w; const float* conv_b; };
struct Seam { bf16x8 qr[8]; bf16x8 st_v0, st_v1, st_k0, st_k1; };
__device__ __forceinline__ int swa_jlo(int P0, int W) { const int lowk = P0 - W + 1; return lowk > 0 ? lowk / KVBLK : 0; }
#define LDG8(base, byteoff) (*(const bf16x8*)((const char*)(base) + (size_t)(byteoff)))
#define VMW() asm volatile("s_waitcnt vmcnt(0)" ::: "memory")
#define VMWN(n) asm volatile("s_waitcnt vmcnt(%0)" :: "i"(n) : "memory")
#define SLOAD_H(Kp, Vp, k0) do { const char* vb_ = (const char*)(Vp) + (size_t)(k0) * (D * 2); const char* kb_ = (const char*)(Kp) + (size_t)(k0) * (D * 2); \
                         S.st_v0 = LDG8(vb_, soff); S.st_v1 = LDG8(vb_ + 32 * D * 2, soff); S.st_k0 = LDG8(kb_, soff); S.st_k1 = LDG8(kb_ + 32 * D * 2, soff); } while (0)
#define SWRITE_HK(bf) do { *(bf16x8*)(K_lds + (bf) * SHM_K + kws) = S.st_k0; *(bf16x8*)(K_lds + (bf) * SHM_K + kws + 32 * 256) = S.st_k1; } while (0)
#define SWRITE_HV(bf) do { *(bf16x8*)(V_lds + (bf) * SHM_V + vst0) = S.st_v0; *(bf16x8*)(V_lds + (bf) * SHM_V + vst1) = S.st_v1; } while (0)
#define SWRITE_H(bf) do { SWRITE_HV(bf); SWRITE_HK(bf); } while (0)
__device__ __forceinline__ void attn_prime(const Blk& cur, int W, char* lds, Seam& S, const int tid) {
    const int wid = __builtin_amdgcn_readfirstlane(tid >> 6), lane = tid & 63, r32 = lane & 31, hi = lane >> 5;
    const int sr = tid >> 4, sc = (tid & 15) * 8, kws = KSWZ(sr, sc * 2); char* K_lds = lds + 2 * SHM_V;
    const unsigned soff = (unsigned)(sr * D + sc) * 2u, qoff = (unsigned)(r32 * D + hi * 8) * 2u;
    const int kb0 = cur.jlo * KVBLK;
    { const char* qb_ = (const char*)cur.Q + (size_t)(wid * QBLK) * (D * 2);
#pragma unroll
    for (int d0 = 0; d0 < 8; ++d0) S.qr[d0] = LDG8(qb_ + d0 * 32, qoff); }
    f32x4 kbv = (f32x4){0.f, 0.f, 0.f, 0.f}; if (cur.KBg) kbv = *(const f32x4*)(cur.KBg + 4 * tid);
    SLOAD_H(cur.K, cur.V, kb0); VMW(); SWRITE_HK(0);
    *(f32x4*)(lds + OFF_KB + 16 * tid) = kbv;
    __syncthreads();
}
__device__ __forceinline__ void attn_block(const Blk& cur, const Blk& nxt, const Phase& P, char* lds, Seam& S, int par, const int tid) {
    const int wid = __builtin_amdgcn_readfirstlane(tid >> 6), lane = tid & 63, r32 = lane & 31, hi = lane >> 5;
    const int W = P.W, skv = P.skv;
    const int j_lo = cur.jlo;
    int j_hi = (cur.P0 + QB - 1) / KVBLK + 1; if (j_hi > skv / KVBLK) j_hi = skv / KVBLK;
    const int NT = j_hi - j_lo;
    const int kbn = nxt.jlo * KVBLK;
    const int qlo = cur.P0 + wid * QBLK, qm = qlo + r32 - 4 * hi;
    char* V_lds = lds; char* K_lds = lds + 2 * SHM_V;
    float* ws = (float*)(lds + OFF_WS) + wid * 64; float* li_l = ws, * al_l = ws + 32;
    const float* kbl = (const float*)(lds + OFF_KB + par * 8192) + 4 * hi;
    float m_reg = ((P.mode == 0) ? ((const float*)(lds + OFF_KB + par * 8192))[cur.P0 + wid * QBLK + r32] : 0.f) - 20.f, l_reg = 0; f32x16 o[4] = {};
    const int sr = tid >> 4, sc = (tid & 15) * 8, vst0 = v_st(sr, sc), vst1 = v_st(32 + sr, sc), kws = KSWZ(sr, sc * 2);
    const unsigned soff = (unsigned)(sr * D + sc) * 2u, qoff = (unsigned)(r32 * D + hi * 8) * 2u;
    const int vb0 = (int)(uintptr_t)V_lds + v_rd_base(lane);
    const bf16_t* Kh = cur.K; const bf16_t* Vh = cur.V;
#define RESC(a) do { if (__any((a) < 1.f)) { if (hi == 0) al_l[r32] = (a); asm volatile("s_waitcnt lgkmcnt(0)" ::: "memory");              \
                     for (int d_ = 0; d_ < 4; ++d_) for (int r = 0; r < 16; ++r) o[d_][r] *= al_l[crow(r, hi)]; } } while (0)
#define KBASE(t) ((j_lo + (t)) * KVBLK)
#define MASKT(P0_, P1_, t) do { const int kb_ = KBASE(t); if (kb_ + KVBLK - 1 > qlo || kb_ <= qlo + QBLK - 1 - W) mask_tile(P0_, P1_, qm - kb_, (unsigned)W); } while (0)
    constexpr int NQL = 8;
#define SEAM_K0() do { VMWN(NQL); SWRITE_HK(0); SBAR(); } while (0)
    f32x16 pA0, pA1, pB0, pB1; float mnA, mnB, alA, alB; bf16x8 pa0, pa1, pa2, pa3;
    SWRITE_HV(0); SBAR();
    if (NT > 1) { SLOAD_H(Kh, Vh, KBASE(1)); }
    SBAR(); qkt<0>(pA0, pA1, K_lds, r32, hi, S.qr);
    MASKT(pA0, pA1, 0); partialSM(pA0, pA1, kbl + KBASE(0), m_reg, mnA, alA);
    if (NT > 1) { VMW(); SWRITE_H(1); }
    __syncthreads();
#define HALF_STEP(PX0, PX1, mnX, alX, PY0, PY1, alY, t, KB, VB, SB) do {                                                      \
        SBAR(); qkt<KB>(PX0, PX1, K_lds, r32, hi, S.qr);                                             \
        finishSM(PY0, PY1, alY, l_reg, pa0, pa1, pa2, pa3); SBAR();                                                           \
        if ((t) + 1 < NT) { SLOAD_H(Kh, Vh, KBASE((t) + 1)); SBAR(); }                                               \
        pv_tile<VB>(o, vb0, pa0, pa1, pa2, pa3); MASKT(PX0, PX1, (t)); partialSM(PX0, PX1, kbl + KBASE(t), m_reg, mnX, alX);                                        \
        __syncthreads();                                                                                                      \
        if ((t) + 1 < NT) { VMW(); SWRITE_H(SB); }                                                                          \
        RESC(alX); __syncthreads(); } while (0)
    for (int t = 1; t + 1 < NT; t += 2) {
        HALF_STEP(pB0, pB1, mnB, alB, pA0, pA1, alA, t, 1, 0, 0);
        HALF_STEP(pA0, pA1, mnA, alA, pB0, pB1, alB, t + 1, 0, 1, 1);
    }
    const bool even = (NT & 1) == 0;
    if (even) { SBAR(); qkt<1>(pB0, pB1, K_lds, r32, hi, S.qr); SBAR(); }
    SLOAD_H(nxt.K, nxt.V, kbn); SBAR();
    { const char* qb_ = (const char*)nxt.Q + (size_t)(wid * QBLK) * (D * 2);
#pragma unroll
    for (int d0 = 0; d0 < 8; ++d0) S.qr[d0] = LDG8(qb_ + d0 * 32, qoff); }
    SBAR();
    finishSM(pA0, pA1, alA, l_reg, pa0, pa1, pa2, pa3); SBAR();
    pv_tile<0>(o, vb0, pa0, pa1, pa2, pa3);
    if (even) { MASKT(pB0, pB1, NT - 1); partialSM(pB0, pB1, kbl + KBASE(NT - 1), m_reg, mnB, alB); __syncthreads(); RESC(alB);
        finishSM(pB0, pB1, alB, l_reg, pa0, pa1, pa2, pa3); SBAR(); pv_tile<1>(o, vb0, pa0, pa1, pa2, pa3); }
    SBAR(); SEAM_K0();
    f32x4 kbv = (f32x4){0.f, 0.f, 0.f, 0.f}; if (nxt.KBg) kbv = *(const f32x4*)(nxt.KBg + 4 * tid);
    if (hi == 0) li_l[r32] = l_reg; asm volatile("s_waitcnt lgkmcnt(0)" ::: "memory");
    float rli[16];
#pragma unroll
    for (int r = 0; r < 16; ++r) rli[r] = __builtin_amdgcn_rcpf(li_l[crow(r, hi)]);
    const int pitch = P.pitch;
    {
        unsigned short* stg = (unsigned short*)(lds + OFF_OST) + wid * (32 * OST_ROW);
#pragma unroll
        for (int r = 0; r < 16; ++r) { const int orow = crow(r, hi);
#pragma unroll
            for (int d0 = 0; d0 < 4; ++d0) { const float v = o[d0][r] * rli[r]; stg[orow * OST_ROW + d0 * 32 + r32] = (unsigned short)(cvt_pk_bf16(v, v) & 0xffffu); } }
        asm volatile("s_waitcnt lgkmcnt(0)" ::: "memory");
        int lane_e = lane; asm volatile("" : "+v"(lane_e));
        const int ch = (lane_e & 15) * 8, rsub = lane_e >> 4;
        if (P.mode == 0) {
            const float* cwp = P.conv_w + cur.col0 + ch; const float* cbp = P.conv_b + cur.col0 + ch;
            const f32x4 w0a = *(const f32x4*)(cwp), w0b = *(const f32x4*)(cwp + 4), w1a = *(const f32x4*)(cwp + DM), w1b = *(const f32x4*)(cwp + DM + 4);
            const f32x4 w2a = *(const f32x4*)(cwp + 2 * DM), w2b = *(const f32x4*)(cwp + 2 * DM + 4), cba = *(const f32x4*)(cbp), cbq = *(const f32x4*)(cbp + 4);
#pragma unroll 2
            for (int p = 0; p < 8; ++p) {
                const int row = p * 4 + rsub, grow = wid * QBLK + row, sp = cur.P0 + grow;
                const size_t idx = cur.ooff + (size_t)grow * DM + ch;
                const u32x4 ov = *(const u32x4*)(stg + row * OST_ROW + ch);
                const u32x4 wcv = *(const u32x4*)(P.WC + idx); const u32x2 sav = *(const u32x2*)(P.SA + idx);
                const u32x4 z0 = *(const u32x4*)(P.Z + idx);
                u32x4 z1 = (u32x4){0u, 0u, 0u, 0u}, z2 = (u32x4){0u, 0u, 0u, 0u};
                if (sp >= 1) z1 = *(const u32x4*)(P.Z + idx - DM);
                if (sp >= 2) z2 = *(const u32x4*)(P.Z + idx - 2 * DM);
                u32x4 res;
#pragma unroll
                for (int e2 = 0; e2 < 4; ++e2) {
                    const float o0 = bf_lo(ov[e2]), o1 = bf_hi(ov[e2]), c0 = bf_lo(wcv[e2]), c1 = bf_hi(wcv[e2]);
                    const float a0 = bf_lo(z0[e2]), a1 = bf_hi(z0[e2]), b0 = bf_lo(z1[e2]), b1 = bf_hi(z1[e2]), d0_ = bf_lo(z2[e2]), d1_ = bf_hi(z2[e2]);
                    const unsigned sw = (e2 < 2) ? sav.x : sav.y; const int sh = (e2 & 1) * 16;
                    const float s0 = (float)((sw >> sh) & 0xffu) * (1.0f / 255.0f), s1 = (float)((sw >> (sh + 8)) & 0xffu) * (1.0f / 255.0f);
                    const int e = 2 * e2;
                    const float k0w0 = (e < 4) ? w0a[e & 3] : w0b[e & 3], k0w1 = (e < 4) ? w1a[e & 3] : w1b[e & 3], k0w2 = (e < 4) ? w2a[e & 3] : w2b[e & 3], k0b = (e < 4) ? cba[e & 3] : cbq[e & 3];
                    const float k1w0 = (e < 4) ? w0a[(e + 1) & 3] : w0b[(e + 1) & 3], k1w1 = (e < 4) ? w1a[(e + 1) & 3] : w1b[(e + 1) & 3], k1w2 = (e < 4) ? w2a[(e + 1) & 3] : w2b[(e + 1) & 3], k1b = (e < 4) ? cba[(e + 1) & 3] : cbq[(e + 1) & 3];
                    const float m0 = s0 * o0 + c0 * (k0b + k0w0 * d0_ + k0w1 * b0 + k0w2 * a0);
                    const float m1 = s1 * o1 + c1 * (k1b + k1w0 * d1_ + k1w1 * b1 + k1w2 * a1);
                    res[e2] = cvt_pk_bf16(m0, m1);
                }
                *(u32x4*)(P.O + idx) = res;
            }
        } else {
#pragma unroll
            for (int p = 0; p < 8; ++p) { const int row = p * 4 + rsub;
                *(u32x4*)(P.O + cur.ooff + (size_t)(wid * QBLK + row) * pitch + ch) = *(const u32x4*)(stg + row * OST_ROW + ch); }
        }
    }
    *(f32x4*)(lds + OFF_KB + (par ^ 1) * 8192 + 16 * tid) = kbv;
    __syncthreads();
#undef RESC
#undef KBASE
#undef MASKT
#undef SEAM_K0
#undef HALF_STEP
}
#undef LDG8
#undef VMW
#undef VMWN
#undef SLOAD_H
#undef SWRITE_HK
#undef SWRITE_HV
#undef SWRITE_H
}

constexpr int NWAVES = 8, NTHREADS = NWAVES * 64;
constexpr int LDS_BYTES = 163840;
static_assert(fa::LDS_BYTES <= LDS_BYTES - 64, "attention LDS");

struct Args { const float* in[24]; float* out; unsigned char* ws; };

__device__ __forceinline__ void transpose_item(const float* W, int ldw, int src_col0, int nvalid, bf16_t* WT, int K, int dest_row0, int k0, LAS float* scr, int lane) {
#pragma unroll
    for (int i = 0; i < 32; ++i) { const int kk = 2 * i + (lane >> 5), c = lane & 31; scr[kk * 33 + c] = (c < nvalid) ? W[(size_t)(k0 + kk) * ldw + src_col0 + c] : 0.f; }
    asm volatile("s_waitcnt lgkmcnt(0)" ::: "memory");
    const int c8 = lane & 7;
#pragma unroll
    for (int j = 0; j < 4; ++j) { const int n = (lane >> 3) + 8 * j; const LAS float* s = scr + (8 * c8) * 33 + n;
        u32x4 o; o.x = cvt_pk_bf16(s[0 * 33], s[1 * 33]); o.y = cvt_pk_bf16(s[2 * 33], s[3 * 33]); o.z = cvt_pk_bf16(s[4 * 33], s[5 * 33]); o.w = cvt_pk_bf16(s[6 * 33], s[7 * 33]);
        *(u32x4*)(WT + (size_t)(dest_row0 + n) * K + k0 + 8 * c8) = o; }
    asm volatile("s_waitcnt lgkmcnt(0)" ::: "memory");
}
__device__ __forceinline__ void conv_matrix(int kind, const float* W, int K, int ldw, int ndb, bf16_t* WT, LAS float* scr, int gw, int ngw, int lane) {
    const int nkb = K / 64; const int nitems = ndb * nkb;
    for (int it = gw; it < nitems; it += ngw) {
        const int db = it / nkb, kb = it - db * nkb; int src = 32 * db, nv = 32;
        if (kind == 1) { const int pn = db >> 3, r = db & 7; src = (r >> 2) * DFF + 128 * pn + (r & 3) * 32; }
        else if (kind == 2) { const int pn = db >> 3, r = db & 7, bj = r >> 2, c0 = (r & 3) * 32;
            if (pn < 24) src = 256 * pn + 32 * r;
            else if (pn < 40) src = (bj ? CC0 : CX0) + 128 * (pn - 24) + c0;
            else if (pn < 56) src = (bj ? GB0 : CB0) + 128 * (pn - 40) + c0;
            else if (pn < 64) src = GA0 + 256 * (pn - 56) + 32 * r;
            else { src = FL0; nv = (r == 0) ? 16 : 0; } }
        transpose_item(W, ldw, src, nv, WT, K, 32 * db, 64 * kb, scr, lane);
    }
}
__device__ __forceinline__ void row_phase(const RowArgs& R, int nrows, int nx, int nloc, int xcd, int rank, int wave, int lane) {
    const int rpx = nrows / nx, st = nloc * NWAVES;
    int lr = rank * NWAVES + wave;
    for (; lr + 3 * st < rpx; lr += 4 * st) rowU_n<4>(R.hin32, R.gpre, R.U, xcd * rpx + lr, st, lane);
    for (; lr < rpx; lr += st) rowU_n<1>(R.hin32, R.gpre, R.U, xcd * rpx + lr, st, lane);
}

typedef __attribute__((address_space(1))) unsigned gu32;
#define XB_TMO      128
#define XB_XCNT(j)  (256  + 64 * (j))
#define XB_XSUB(j)  (1280 + 64 * (j))
#define XB_XGEN(j)  (2304 + 64 * (j))
#define XB_TOP      3328
#define XB_TOPGEN   3392
#define XCD_BAR_WORDS 3456
#define XB_SPIN_CAP (1u << 18)

__device__ __forceinline__ unsigned xb_ld(unsigned* p)              { return __hip_atomic_load(p, __ATOMIC_RELAXED, __HIP_MEMORY_SCOPE_AGENT); }
__device__ __forceinline__ unsigned xb_add(unsigned* p, unsigned v) { return __hip_atomic_fetch_add(p, v, __ATOMIC_RELAXED, __HIP_MEMORY_SCOPE_AGENT); }
__device__ __forceinline__ unsigned xb_xcc_id() { return (unsigned)__builtin_amdgcn_s_getreg((3 << 11) | 20) & 0xFu; }
#define XB_SPIN(cond, bar) do { unsigned _sp = 0; while (cond) { __builtin_amdgcn_s_sleep(1); \
    if ((++_sp & 255u) == 0u) { if (xb_ld(&(bar)[XB_TMO])) break; if (_sp > XB_SPIN_CAP) { atomicAdd(&(bar)[XB_TMO], 1u); break; } } } } while (0)

struct XcdBarrier {
    unsigned* bar; unsigned x;
    volatile LAS unsigned* st;
};

__device__ __forceinline__ XcdBarrier xcd_barrier_post(unsigned* bar, volatile LAS unsigned* st) {
    XcdBarrier b; b.bar = bar; b.x = xb_xcc_id(); b.st = st;
    if (threadIdx.x == 0) (void)xb_add(&bar[XB_XCNT(b.x)], 1u);
    return b;
}
__device__ __forceinline__ void xcd_barrier_complete(unsigned* bar, unsigned x, unsigned& nloc, unsigned& nx) {
    const unsigned G = gridDim.x * gridDim.y * gridDim.z;
    unsigned sum, cnt, mine, sp = 0u;
    for (;;) {
        sum = 0u; cnt = 0u; mine = 0u;
#pragma unroll
        for (unsigned j = 0; j < 16; ++j) { const unsigned c = xb_ld(&bar[XB_XCNT(j)]); sum += c; cnt += (c > 0u) ? 1u : 0u; mine = (j == x) ? c : mine; }
        if (sum == G) break;
        __builtin_amdgcn_s_sleep(1);
        if ((++sp & 255u) == 0u) { if (xb_ld(&bar[XB_TMO])) break; if (sp > XB_SPIN_CAP) { atomicAdd(&bar[XB_TMO], 1u); break; } }
    }
    nloc = mine > 0u ? mine : 1u; nx = cnt > 0u ? cnt : 1u;
}

__device__ __forceinline__ void xcd_barrier(const XcdBarrier& b) {
    asm volatile("s_waitcnt vmcnt(0)" ::: "memory");
    __syncthreads();
    if (threadIdx.x == 0) {
        unsigned* bar = b.bar;
        __builtin_amdgcn_s_waitcnt(0);
        unsigned nloc = b.st[0], nx = b.st[1];
        if (nloc == 0u) { xcd_barrier_complete(bar, b.x, nloc, nx); b.st[0] = nloc; b.st[1] = nx; }
        const unsigned old = xb_add(&bar[XB_XSUB(b.x)], 1u);
        const unsigned gen = old / nloc;
        if (old + 1u == (gen + 1u) * nloc) {
            __builtin_amdgcn_fence(__ATOMIC_RELEASE, "");
            asm volatile("s_waitcnt vmcnt(0)" ::: "memory");
            const unsigned og = xb_add(&bar[XB_TOP], 1u);
            const unsigned tg = og / nx;
            if (og + 1u == (tg + 1u) * nx) xb_add(&bar[XB_TOPGEN], 1u);
            else XB_SPIN(xb_ld(&bar[XB_TOPGEN]) == tg, bar);
            __builtin_amdgcn_fence(__ATOMIC_ACQUIRE, "");
            xb_add(&bar[XB_XGEN(b.x)], 1u);
            asm volatile("s_waitcnt vmcnt(0)" ::: "memory");
        } else {
            XB_SPIN(xb_ld(&bar[XB_XGEN(b.x)]) == gen, bar);
            __builtin_amdgcn_fence(__ATOMIC_ACQUIRE, "");
            asm volatile("s_waitcnt vmcnt(0)" ::: "memory");
        }
    }
    __syncthreads();
}

enum { F_PREP = 1, F_CUMSUM = 2, F_GEMM = 4, F_ROW = 8, F_ROWU = 16, F_ATTN = 64 };
enum { E_SWIGLU = 0, E_ROWSS, E_IN, E_HEADS };

__device__ __forceinline__ bool attn_getblk(int sub, int k, int nx, int nloc, int xcd, int rank, unsigned char* ws, fa::Blk& B) {
    if (sub == 0) { const int per = (BATCH * NH) / nx, l = rank + (k >> 3) * nloc; if (l >= per) return false;
        const int bh = xcd * per + l, qb = 7 - (k & 7), b = bh >> 4, h = bh & 15;
        B.Q = (const bf16_t*)(ws + WS_QH) + ((size_t)bh * SEQ + qb * 256) * 128; B.K = (const bf16_t*)(ws + WS_KH) + (size_t)bh * SEQ * 128; B.V = (const bf16_t*)(ws + WS_VH) + (size_t)bh * SEQ * 128;
        B.KBg = (const float*)(ws + WS_KB) + (size_t)bh * SEQ; B.P0 = qb * 256; B.col0 = h * 128; B.ooff = ((size_t)b * SEQ + qb * 256) * DM + h * 128;
        B.jlo = ((const int*)(ws + WS_CTL))[CW_JLO + bh * 8 + qb]; return true; }
    else { const int per = (BATCH * MH * 8) / nx, l = rank + k * nloc; if (l >= per) return false;
        const int L = xcd * per + l;
        const int bh = L >> 3, qb = L & 7, b = bh >> 2, h = bh & 3;
        B.Q = (const bf16_t*)(ws + WS_QM) + ((size_t)bh * SEQ + qb * 256) * 128; B.K = (const bf16_t*)(ws + WS_KM) + (size_t)bh * NMEM * 128; B.V = (const bf16_t*)(ws + WS_VM) + (size_t)bh * NMEM * 128;
        B.KBg = nullptr; B.P0 = 4096; B.col0 = h * 128; B.ooff = ((size_t)b * SEQ + qb * 256) * MW + h * 128; B.jlo = 0; return true; }
}

constexpr int LDS_MISC = LDS_BYTES - 64;

__global__ void __launch_bounds__(NTHREADS, 2) fwd_megakernel(Args args) {
    extern __shared__ __attribute__((aligned(16))) unsigned char lds[];
    cg::grid_group grid = cg::this_grid();
    {
        volatile LAS unsigned* st0 = (volatile LAS unsigned*)((LAS unsigned char*)lds + LDS_MISC);
        unsigned* ctl = (unsigned*)(args.ws + WS_CTL);
        if (threadIdx.x == 0) { st0[0] = 0u; st0[1] = 0u; const unsigned x = xb_xcc_id(); st0[2] = x; st0[3] = xb_add(&ctl[CW_RANK + 64 * (x & 15u)], 1u); }
        __syncthreads();
        (void)xcd_barrier_post(ctl, st0);
        grid.sync();
        if (threadIdx.x == 0) {
            const unsigned G = gridDim.x; bool ok = (G % 8u) == 0u;
            for (unsigned j = 0; j < 16; ++j) { const unsigned c = xb_ld(&ctl[CW_RANK + 64 * j]); if (c != (j < 8 ? G / 8u : 0u)) ok = false; }
            if (ok) { st0[4] = 8u; st0[5] = G / 8u; } else { st0[2] = 0u; st0[3] = blockIdx.x; st0[4] = 1u; st0[5] = G; }
        }
        __syncthreads();
    }
#ifdef REPEAT_PH
    int rep_done = 0;
#endif
#pragma nounroll
    for (int ph = 0; ph <= LAST_PHASE; ++ph) {
        size_t wz = 0; asm volatile("" : "+s"(wz));
        unsigned char* ws = args.ws + wz;
        bf16_t* ubuf = (bf16_t*)(args.out + wz);
        int tid = threadIdx.x; asm volatile("" : "+v"(tid));
        int zz = 0; asm volatile("" : "+s"(zz));
#define IN(i) (args.in[(i) + zz])
        const int lane = tid & 63, wave = __builtin_amdgcn_readfirstlane(tid >> 6);
        LAS unsigned char* ldsl = (LAS unsigned char*)lds;
        unsigned moff = LDS_MISC; asm volatile("" : "+s"(moff));
        volatile LAS unsigned* misc = (volatile LAS unsigned*)(ldsl + moff);
        const int xcd = __builtin_amdgcn_readfirstlane((int)misc[2]), rank = __builtin_amdgcn_readfirstlane((int)misc[3]);
        const int nx = __builtin_amdgcn_readfirstlane((int)misc[4]), nloc = __builtin_amdgcn_readfirstlane((int)misc[5]);
        unsigned flags = 0; size_t offA = 0, offB = 0; int gM = M, gN = 0, gK = 0, epi = 0;
        int i_gpost = 0, i_gpre = 0, hin_x = 0, sub = 0; float r_alpha = 1.f;
        switch (ph) {
            case 0: flags = F_PREP; break;
            case 1: flags = F_GEMM; offA = WS_X0; offB = WS_W13A; gN = 2 * DFF; gK = DM; epi = E_SWIGLU; break;
            case 2: flags = F_GEMM | F_ROWU; offA = WS_HID; offB = WS_W2A; gN = DM; gK = DFF; epi = E_ROWSS; hin_x = 1; r_alpha = 0.5f; i_gpost = 5; i_gpre = 6; sub = 1; break;
            case 3: flags = F_GEMM; offA = WS_X0; offB = WS_WIN; gN = NIN; gK = DM; epi = E_IN; break;
            case 4: flags = F_CUMSUM; break;
            case 5: flags = F_ATTN; sub = 0; break;
            case 6: flags = F_GEMM | F_ROWU; offA = WS_X0; offB = WS_WOUT; gN = DM; gK = DM; epi = E_ROWSS; r_alpha = 1.f; i_gpost = 13; i_gpre = 14; sub = 2; break;
            case 7: flags = F_GEMM; offA = WS_X0; offB = WS_WMQ; gN = MW; gK = DM; epi = E_HEADS; sub = 0; break;
            case 8: flags = F_ATTN; sub = 1; break;
            case 9: flags = F_GEMM | F_ROWU; offA = WS_OM; offB = WS_WMO; gN = DM; gK = MW; epi = E_ROWSS; r_alpha = 1.f; i_gpost = 19; i_gpre = 20; sub = 3; break;
            case 10: flags = F_GEMM; offA = WS_X0; offB = WS_W13B; gN = 2 * DFF; gK = DM; epi = E_SWIGLU; break;
            default: flags = F_GEMM; offA = WS_HID; offB = WS_W2B; gN = DM; gK = DFF; epi = E_ROWSS; r_alpha = 0.5f; i_gpost = 23; i_gpre = 23; sub = 4; break;
        }
        if (flags & F_PREP) {
            const int gw = (xcd * nloc + rank) * NWAVES + wave, ngw = nx * nloc * NWAVES;
            LAS float* scr = (LAS float*)(ldsl + wave * 16384);
            conv_matrix(1, IN(3), DM, 2 * DFF, (2 * DFF) / 32, (bf16_t*)(ws + WS_W13A), scr, gw, ngw, lane);
            conv_matrix(0, IN(4), DFF, DM, DM / 32, (bf16_t*)(ws + WS_W2A), scr, gw, ngw, lane);
            conv_matrix(2, IN(7), DM, WIN_COLS, NIN / 32, (bf16_t*)(ws + WS_WIN), scr, gw, ngw, lane);
            conv_matrix(0, IN(12), DM, DM, DM / 32, (bf16_t*)(ws + WS_WOUT), scr, gw, ngw, lane);
            conv_matrix(0, IN(16), DM, MW, MW / 32, (bf16_t*)(ws + WS_WMQ), scr, gw, ngw, lane);
            conv_matrix(0, IN(17), DM, 2 * MW, (2 * MW) / 32, (bf16_t*)(ws + WS_WMKV), scr, gw, ngw, lane);
            conv_matrix(0, IN(18), MW, DM, DM / 32, (bf16_t*)(ws + WS_WMO), scr, gw, ngw, lane);
            conv_matrix(1, IN(21), DM, 2 * DFF, (2 * DFF) / 32, (bf16_t*)(ws + WS_W13B), scr, gw, ngw, lane);
            conv_matrix(0, IN(22), DFF, DM, DM / 32, (bf16_t*)(ws + WS_W2B), scr, gw, ngw, lane);
            { RowArgs R{IN(0), ubuf, nullptr, nullptr, nullptr, IN(2), ubuf, 1.f}; row_phase(R, M, nx, nloc, xcd, rank, wave, lane); }
            { RowArgs R{IN(1), ubuf, nullptr, nullptr, nullptr, IN(15), (bf16_t*)(ws + WS_MEMN), 1.f}; row_phase(R, MMEM, nx, nloc, xcd, rank, wave, lane); }
        }
        if (flags & F_CUMSUM) {
            LAS float* wtot = (LAS float*)ldsl;
            LAS float* kbs = (LAS float*)(ldsl + 1024);
            const float* LOGF = (const float*)(ws + WS_LOGF); float* KB = (float*)(ws + WS_KB);
            const int per = (BATCH * NH) / nx;
            for (int li = rank; li < per; li += nloc) {
                const int bh = xcd * per + li;
                const int b = bh >> 4, h = bh & 15;
                float v[4];
#pragma unroll
                for (int j = 0; j < 4; ++j) v[j] = LOGF[((size_t)b * SEQ + 4 * tid + j) * 16 + h];
                v[1] += v[0]; v[2] += v[1]; v[3] += v[2];
                float inc = v[3];
#pragma unroll
                for (int o = 1; o < 64; o <<= 1) { const float t = __shfl_up(inc, o); if (lane >= o) inc += t; }
                float qn = 0.f, kn = 0.f;
                {
                    const bf16_t* nq = (const bf16_t*)(ws + WS_NRM); const bf16_t* nk = nq + (size_t)M * 64;
#pragma unroll
                    for (int r = 0; r < 4; ++r) { const size_t o_ = (((size_t)b * SEQ + 4 * tid + r) * 16 + h) * 4;
                        const u32x2 a = *(const u32x2*)(nq + o_), k2v = *(const u32x2*)(nk + o_);
                        qn = fmaxf(qn, (bf_lo(a.x) + bf_hi(a.x)) + (bf_lo(a.y) + bf_hi(a.y))); kn = fmaxf(kn, (bf_lo(k2v.x) + bf_hi(k2v.x)) + (bf_lo(k2v.y) + bf_hi(k2v.y))); }
                }
#pragma unroll
                for (int o = 1; o < 64; o <<= 1) { qn = fmaxf(qn, __shfl_xor(qn, o)); kn = fmaxf(kn, __shfl_xor(kn, o)); }
                if (lane == 63) { wtot[wave] = inc; wtot[8 + wave] = qn; wtot[16 + wave] = kn; }
                __syncthreads();
                float pre = inc - v[3];
                for (int w = 0; w < wave; ++w) pre += wtot[w];
                f32x4 o4;
#pragma unroll
                for (int j = 0; j < 4; ++j) o4[j] = -(pre + v[j]) * LOG2E;
                *(f32x4*)(KB + (size_t)bh * SEQ + 4 * tid) = o4;
                *(LAS f32x4*)(kbs + 4 * tid) = o4;
                __syncthreads();
                if (tid < 8) {
                    float q2 = wtot[8 + tid], k2 = 0.f;
                    for (int w = 0; w <= tid; ++w) k2 = fmaxf(k2, wtot[16 + w]);
                    const float T = 2.0f * sqrtf(q2 * k2) * fa::C2 * 1.001f + 40.0f;
                    const int P0 = tid * 256; int j = P0 / 64; const float kb0 = kbs[P0];
                    while (j > 0 && !(kb0 - kbs[64 * j - 1] > T)) --j;
                    ((int*)(ws + WS_CTL))[CW_JLO + bh * 8 + tid] = j;
                }
                __syncthreads();
            }
        }
        if (flags & F_GEMM) {
            const int npass = (ph == 3) ? 2 : 1;
#pragma nounroll
            for (int pass = 0; pass < npass; ++pass) {
                int rk = rank;
                if (pass == 1) {
                    offA = WS_MEMN; offB = WS_WMKV; gM = MMEM; gN = 2 * MW; gK = DM; epi = E_HEADS; sub = 1; rk = (rank + nloc / 2) % nloc; }
                pg8::Gemm g{(offA == WS_X0) ? (const bf16_t*)ubuf : (const bf16_t*)(ws + offA), (const bf16_t*)(ws + offB), gM, gN, gK}; pg8::StaticOrder S; S.init(gM, gN, nx, nloc, xcd, rk);
                switch (epi) {
                    case E_SWIGLU: { pg8::EpiSwiGLU E{(bf16_t*)(ws + WS_HID)}; pg8::gemm_phase<pg8::EpiSwiGLU>(ldsl, g, S, E, tid); } break;
                    case E_ROWSS: { bf16_t* HB = (bf16_t*)(ws + WS_X0); const bool fin = !(flags & F_ROWU);
                        RowArgs R{hin_x ? IN(0) : (const float*)nullptr, HB, HB, fin ? (args.out + wz) : (float*)nullptr, IN(i_gpost), IN(i_gpre), fin ? (bf16_t*)nullptr : ubuf, r_alpha};
                        pg8::EpiRowSS E{(bf16_t*)(ws + WS_X1), (float*)(ws + WS_SS), R, (unsigned*)(ws + WS_CTL) + CW_PANEL, 8u * (unsigned)sub};
                        pg8::gemm_phase<pg8::EpiRowSS>(ldsl, g, S, E, tid); } break;
                    case E_IN: { pg8::EpiIn E{(bf16_t*)(ws + WS_QH), (size_t)(WS_KH - WS_QH) / 2, (bf16_t*)(ws + WS_Z), (bf16_t*)(ws + WS_WC), (unsigned char*)(ws + WS_SA), (float*)(ws + WS_LOGF), IN(9), IN(8), (bf16_t*)(ws + WS_NRM)};
                                 pg8::gemm_phase<pg8::EpiIn>(ldsl, g, S, E, tid); } break;
                    default: { pg8::EpiHeads E{(bf16_t*)(ws + (sub ? WS_KM : WS_QM)), (size_t)(WS_VM - WS_KM) / 2, 2, sub ? 8 : 11}; pg8::gemm_phase<pg8::EpiHeads>(ldsl, g, S, E, tid); } break;
                }
            }
        }
        if (flags & F_ATTN) {
            fa::Phase P;
            if (sub == 0) { P.mode = 0; P.skv = SEQ; P.W = 1 << 24; P.pitch = DM; P.O = ubuf; P.SA = (const unsigned char*)(ws + WS_SA); P.WC = (const bf16_t*)(ws + WS_WC); P.Z = (const bf16_t*)(ws + WS_Z); P.conv_w = IN(10); P.conv_b = IN(11); }
            else { P.mode = 1; P.skv = NMEM; P.W = 1 << 24; P.pitch = MW; P.O = (bf16_t*)(ws + WS_OM); P.SA = nullptr; P.WC = nullptr; P.Z = nullptr; P.conv_w = nullptr; P.conv_b = nullptr; }
            fa::Blk cur, nxt; fa::Seam S;
            if (attn_getblk(sub, 0, nx, nloc, xcd, rank, ws, cur)) {
                fa::attn_prime(cur, P.W, (char*)lds, S, tid);
                for (int k = 0;; ++k) {
                    const bool has = attn_getblk(sub, k + 1, nx, nloc, xcd, rank, ws, nxt); if (!has) nxt = cur;
                    fa::attn_block(cur, nxt, P, (char*)lds, S, k & 1, tid);
                    if (!has) break;
                    cur = nxt;
                }
            }
        }
        if (ph < LAST_PHASE) { XcdBarrier b_; b_.bar = (unsigned*)(ws + WS_CTL); b_.x = xb_xcc_id(); unsigned mo2 = LDS_MISC; asm volatile("" : "+s"(mo2)); b_.st = (volatile LAS unsigned*)(ldsl + mo2); xcd_barrier(b_); }
#ifdef REPEAT_PH
        if (ph == REPEAT_PH && !rep_done) { rep_done = 1; --ph; }
#endif
    }
#undef IN
}

extern "C" void kernel_launch(void* const* d_in, const int* in_sizes, int n_in, void* d_out, int out_size, void* d_ws, size_t ws_size, hipStream_t stream) {
    static int grid = 0;
    if (grid == 0) {
        if (n_in != 24 || in_sizes[0] != M * DM || out_size != M * DM || ws_size < WS_END) {
            fprintf(stderr, "kernel_launch: unexpected shapes (n_in %d, in0 %d, out %d, ws %zu need %zu); nothing launched\n", n_in, n_in > 0 ? in_sizes[0] : -1, out_size, ws_size, (size_t)WS_END);
            grid = -1; return; }
        int dev = 0, cus = 0, per_cu = 0;
        (void)hipGetDevice(&dev);
        (void)hipDeviceGetAttribute(&cus, hipDeviceAttributeMultiprocessorCount, dev);
        if (hipFuncSetAttribute((const void*)fwd_megakernel, hipFuncAttributeMaxDynamicSharedMemorySize, LDS_BYTES) != hipSuccess) { fprintf(stderr, "kernel_launch: hipFuncSetAttribute failed\n"); grid = -1; return; }
        if (hipOccupancyMaxActiveBlocksPerMultiprocessor(&per_cu, (const void*)fwd_megakernel, NTHREADS, LDS_BYTES) != hipSuccess || per_cu < 1) { fprintf(stderr, "kernel_launch: occupancy query gave %d\n", per_cu); per_cu = 1; }
        (void)hipGetLastError();
        grid = cus * per_cu;
    }
    if (grid < 0) return;
    if (hipMemsetAsync((char*)d_ws + WS_CTL, 0, CTL_ZERO_BYTES, stream) != hipSuccess) { fprintf(stderr, "kernel_launch: memset failed\n"); return; }
    Args a{};
    for (int i = 0; i < 24; ++i) a.in[i] = (const float*)d_in[i];
    a.out = (float*)d_out; a.ws = (unsigned char*)d_ws;
    void* kargs[] = {&a};
    hipError_t e = hipLaunchCooperativeKernel((const void*)fwd_megakernel, dim3(grid), dim3(NTHREADS), kargs, LDS_BYTES, stream);
    if (e != hipSuccess) fprintf(stderr, "cooperative launch failed: %s (grid %d)\n", hipGetErrorString(e), grid);
}
```

```cpp
#include <hip/hip_runtime.h>
#include <hip/hip_bf16.h>
#include <hip/hip_cooperative_groups.h>
#include <cstdio>
#include <cstdint>
namespace cg = cooperative_groups;

#ifndef LAST_PHASE
#define LAST_PHASE 11
#endif

#define LAS __attribute__((address_space(3)))
typedef unsigned short bf16_t;
typedef short bf16x8 __attribute__((ext_vector_type(8)));
typedef short s16x4 __attribute__((ext_vector_type(4)));
typedef float f32x4 __attribute__((ext_vector_type(4)));
typedef float f32x16 __attribute__((ext_vector_type(16)));
typedef unsigned u32x4 __attribute__((ext_vector_type(4)));
typedef unsigned u32x2 __attribute__((ext_vector_type(2)));

constexpr int BATCH = 16, SEQ = 2048, DM = 2048, M = BATCH * SEQ, NMEM = 256, MMEM = BATCH * NMEM, DFF = 5632;
constexpr int NH = 16, MH = 4, MW = 512;
constexpr int WIN_COLS = 16400, NIN = 65 * 256;
constexpr int CX0 = 6160, CB0 = 8208, CC0 = 10256, GA0 = 12304, GB0 = 14352, FL0 = 6144;
constexpr float EPS = 1e-6f;
constexpr float LOG2E = 1.4426950408889634f;

constexpr size_t MiB = 1u << 20;
constexpr size_t WS_X0 = 0;
constexpr size_t WS_BIG = 128 * MiB;
constexpr size_t WS_HID = WS_BIG;
constexpr size_t WS_W13A = WS_BIG + 352 * MiB;
constexpr size_t WS_W2A = WS_BIG + 396 * MiB;
constexpr size_t WS_QM = WS_BIG + 418 * MiB;
constexpr size_t WS_OM = WS_BIG + 450 * MiB;
constexpr size_t WS_QH = WS_BIG, WS_KH = WS_BIG + 128 * MiB, WS_VH = WS_BIG + 256 * MiB;
constexpr size_t WS_Z = WS_BIG + 384 * MiB, WS_WC = WS_BIG + 512 * MiB, WS_SA = WS_BIG + 640 * MiB;
constexpr size_t WS_X1 = WS_BIG + 512 * MiB;
constexpr size_t WS_WIN = 832 * MiB;
constexpr size_t WS_WOUT = 897 * MiB, WS_WMQ = 905 * MiB, WS_WMKV = 907 * MiB, WS_WMO = 911 * MiB;
constexpr size_t WS_W13B = 913 * MiB, WS_W2B = 957 * MiB;
constexpr size_t WS_MEMN = 979 * MiB;
constexpr size_t WS_KM = 995 * MiB, WS_VM = 999 * MiB;
constexpr size_t WS_SS = 1003 * MiB;
constexpr size_t WS_LOGF = 1007 * MiB;
constexpr size_t WS_KB = 1009 * MiB;
constexpr size_t WS_CTL = 1011 * MiB, CTL_ZERO_BYTES = 131072;
constexpr size_t WS_NRM = 1012 * MiB;
constexpr size_t WS_END = 1020 * MiB;
constexpr int CW_JLO = 12288;
constexpr int CW_PANEL = 16384;
constexpr int CW_RANK = 8192;

__device__ __forceinline__ unsigned cvt_pk_bf16(float lo, float hi) { unsigned r; asm volatile("v_cvt_pk_bf16_f32 %0, %1, %2" : "=v"(r) : "v"(lo), "v"(hi)); return r; }
__device__ __forceinline__ float bf_lo(unsigned w) { return __uint_as_float(w << 16); }
__device__ __forceinline__ float bf_hi(unsigned w) { return __uint_as_float(w & 0xffff0000u); }
__device__ __forceinline__ float bf1(bf16_t w) { return __uint_as_float(((unsigned)w) << 16); }
__device__ __forceinline__ float sigmoidf_(float x) { return __builtin_amdgcn_rcpf(1.0f + __builtin_amdgcn_exp2f(-x * LOG2E)); }
__device__ __forceinline__ u32x4 pack8u(f32x4 a, f32x4 b) { u32x4 w; w.x = cvt_pk_bf16(a[0], a[1]); w.y = cvt_pk_bf16(a[2], a[3]); w.z = cvt_pk_bf16(b[0], b[1]); w.w = cvt_pk_bf16(b[2], b[3]); return w; }


__device__ __forceinline__ float wave_sum(float v) {
#pragma unroll
    for (int o = 1; o < 64; o <<= 1) v += __shfl_xor(v, o);
    return v;
}
struct RowArgs { const float* hin32; const bf16_t* hin16; bf16_t* hout16; float* outf; const float* gpost; const float* gpre; bf16_t* U; float alpha; };
__device__ __forceinline__ void row_one(const RowArgs& R, const bf16_t* F, const float* ss, int row, int lane) {
    f32x4 v[8];
    if (R.hin32) { const f32x4* xr = (const f32x4*)(R.hin32 + (size_t)row * DM) + lane;
#pragma unroll
        for (int j = 0; j < 8; ++j) v[j] = xr[64 * j]; }
    else { const u32x2* hr = (const u32x2*)(R.hin16 + (size_t)row * DM) + lane;
#pragma unroll
        for (int j = 0; j < 8; ++j) { const u32x2 w = hr[64 * j]; v[j][0] = bf_lo(w.x); v[j][1] = bf_hi(w.x); v[j][2] = bf_lo(w.y); v[j][3] = bf_hi(w.y); } }
    if (F) {
        float s = ss[(size_t)row * 32 + (lane & 31)];
#pragma unroll
        for (int o = 1; o < 32; o <<= 1) s += __shfl_xor(s, o);
        const float rs = rsqrtf(s * (1.0f / DM) + EPS) * R.alpha;
        const u32x2* fr = (const u32x2*)(F + (size_t)row * DM) + lane;
#pragma unroll
        for (int j = 0; j < 8; ++j) { const u32x2 w = fr[64 * j]; const f32x4 gp = ((const f32x4*)R.gpost)[lane + 64 * j];
            v[j][0] += bf_lo(w.x) * rs * gp[0]; v[j][1] += bf_hi(w.x) * rs * gp[1]; v[j][2] += bf_lo(w.y) * rs * gp[2]; v[j][3] += bf_hi(w.y) * rs * gp[3]; }
        if (R.outf) { f32x4* ho = (f32x4*)(R.outf + (size_t)row * DM) + lane;
#pragma unroll
            for (int j = 0; j < 8; ++j) ho[64 * j] = v[j]; }
        else { u32x2* ho = (u32x2*)(R.hout16 + (size_t)row * DM) + lane;
#pragma unroll
            for (int j = 0; j < 8; ++j) { u32x2 w; w.x = cvt_pk_bf16(v[j][0], v[j][1]); w.y = cvt_pk_bf16(v[j][2], v[j][3]); ho[64 * j] = w; } }
    }
    if (R.U) {
        float q = 0.f;
#pragma unroll
        for (int j = 0; j < 8; ++j) q += (v[j][0] * v[j][0] + v[j][1] * v[j][1]) + (v[j][2] * v[j][2] + v[j][3] * v[j][3]);
        q = wave_sum(q);
        const float r2 = rsqrtf(q * (1.0f / DM) + EPS);
        u32x2* uo = (u32x2*)(R.U + (size_t)row * DM) + lane;
#pragma unroll
        for (int j = 0; j < 8; ++j) { const f32x4 g = ((const f32x4*)R.gpre)[lane + 64 * j]; u32x2 w;
            w.x = cvt_pk_bf16(v[j][0] * r2 * g[0], v[j][1] * r2 * g[1]); w.y = cvt_pk_bf16(v[j][2] * r2 * g[2], v[j][3] * r2 * g[3]); uo[64 * j] = w; }
    }
}

template <int NR>
__device__ __forceinline__ void row_n(const RowArgs& R, const bf16_t* F, const float* ss, int row0, int stride, int lane) {
    f32x4 v[NR][8]; u32x2 fw[NR][8]; float s[NR];
#pragma unroll
    for (int n = 0; n < NR; ++n) { const int row = row0 + n * stride;
        s[n] = ss[(size_t)row * 32 + (lane & 31)];
        if (R.hin32) { const f32x4* xr = (const f32x4*)(R.hin32 + (size_t)row * DM) + lane;
#pragma unroll
            for (int j = 0; j < 8; ++j) v[n][j] = xr[64 * j]; }
        else { const u32x2* hr = (const u32x2*)(R.hin16 + (size_t)row * DM) + lane;
#pragma unroll
            for (int j = 0; j < 8; ++j) { const u32x2 w = hr[64 * j]; v[n][j][0] = bf_lo(w.x); v[n][j][1] = bf_hi(w.x); v[n][j][2] = bf_lo(w.y); v[n][j][3] = bf_hi(w.y); } }
        const u32x2* fr = (const u32x2*)(F + (size_t)row * DM) + lane;
#pragma unroll
        for (int j = 0; j < 8; ++j) fw[n][j] = fr[64 * j]; }
#pragma unroll
    for (int n = 0; n < NR; ++n) {
#pragma unroll
        for (int o = 1; o < 32; o <<= 1) s[n] += __shfl_xor(s[n], o);
        s[n] = rsqrtf(s[n] * (1.0f / DM) + EPS) * R.alpha; }
#pragma unroll
    for (int j = 0; j < 8; ++j) { const f32x4 gp = ((const f32x4*)R.gpost)[lane + 64 * j];
#pragma unroll
        for (int n = 0; n < NR; ++n) { const u32x2 w = fw[n][j]; const float rs = s[n];
            v[n][j][0] += bf_lo(w.x) * rs * gp[0]; v[n][j][1] += bf_hi(w.x) * rs * gp[1]; v[n][j][2] += bf_lo(w.y) * rs * gp[2]; v[n][j][3] += bf_hi(w.y) * rs * gp[3]; } }
#pragma unroll
    for (int n = 0; n < NR; ++n) { const int row = row0 + n * stride;
        if (R.outf) { f32x4* ho = (f32x4*)(R.outf + (size_t)row * DM) + lane;
#pragma unroll
            for (int j = 0; j < 8; ++j) ho[64 * j] = v[n][j]; }
        else { u32x2* ho = (u32x2*)(R.hout16 + (size_t)row * DM) + lane;
#pragma unroll
            for (int j = 0; j < 8; ++j) { u32x2 w; w.x = cvt_pk_bf16(v[n][j][0], v[n][j][1]); w.y = cvt_pk_bf16(v[n][j][2], v[n][j][3]); ho[64 * j] = w; } } }
    if (R.U) {
        float q[NR];
#pragma unroll
        for (int n = 0; n < NR; ++n) { q[n] = 0.f;
#pragma unroll
            for (int j = 0; j < 8; ++j) q[n] += (v[n][j][0] * v[n][j][0] + v[n][j][1] * v[n][j][1]) + (v[n][j][2] * v[n][j][2] + v[n][j][3] * v[n][j][3]);
            q[n] = rsqrtf(wave_sum(q[n]) * (1.0f / DM) + EPS); }
#pragma unroll
        for (int j = 0; j < 8; ++j) { const f32x4 g = ((const f32x4*)R.gpre)[lane + 64 * j];
#pragma unroll
            for (int n = 0; n < NR; ++n) { u32x2 w; const float r2 = q[n];
                w.x = cvt_pk_bf16(v[n][j][0] * r2 * g[0], v[n][j][1] * r2 * g[1]); w.y = cvt_pk_bf16(v[n][j][2] * r2 * g[2], v[n][j][3] * r2 * g[3]);
                ((u32x2*)(R.U + (size_t)(row0 + n * stride) * DM) + lane)[64 * j] = w; } }
    }
}

template <int NR>
__device__ __forceinline__ void rowU_n(const float* hin32, const float* gpre, bf16_t* U, int row0, int stride, int lane) {
    f32x4 v[NR][8]; float q[NR];
#pragma unroll
    for (int n = 0; n < NR; ++n) { const f32x4* xr = (const f32x4*)(hin32 + (size_t)(row0 + n * stride) * DM) + lane;
#pragma unroll
        for (int j = 0; j < 8; ++j) v[n][j] = xr[64 * j]; }
#pragma unroll
    for (int n = 0; n < NR; ++n) { q[n] = 0.f;
#pragma unroll
        for (int j = 0; j < 8; ++j) q[n] += (v[n][j][0] * v[n][j][0] + v[n][j][1] * v[n][j][1]) + (v[n][j][2] * v[n][j][2] + v[n][j][3] * v[n][j][3]);
        q[n] = rsqrtf(wave_sum(q[n]) * (1.0f / DM) + EPS); }
#pragma unroll
    for (int j = 0; j < 8; ++j) { const f32x4 g = ((const f32x4*)gpre)[lane + 64 * j];
#pragma unroll
        for (int n = 0; n < NR; ++n) { u32x2 w; const float r2 = q[n];
            w.x = cvt_pk_bf16(v[n][j][0] * r2 * g[0], v[n][j][1] * r2 * g[1]); w.y = cvt_pk_bf16(v[n][j][2] * r2 * g[2], v[n][j][3] * r2 * g[3]);
            ((u32x2*)(U + (size_t)(row0 + n * stride) * DM) + lane)[64 * j] = w; } }
}

namespace pg8 {
constexpr int BM = 256, BK = 64, HALF = 128, HTB = HALF * BK * 2, STAGE_BYTES = 8 * HTB, NXCD = 8, WGM = 4;
__host__ __device__ __forceinline__ int lds_byte(int r, int c) { const int st = (r >> 4) * 2 + (c >> 5), rr = r & 15, cc = c & 31, ob = rr * 64 + cc * 2; return st * 1024 + (ob ^ (((ob >> 9) & 1) << 5)); }
__host__ __device__ __forceinline__ void stage_rc(int b, int& R, int& C) { const int st = b / 1024, sb = b % 1024, swz = sb ^ (((sb >> 9) & 1) << 5); R = (st >> 1) * 16 + swz / 64; C = (st & 1) * 32 + (swz % 64) / 2; }
__host__ __device__ __forceinline__ int perm32(int rho) { const int n = rho >> 4, i = rho & 15; return 8 * (i >> 2) + 4 * n + (i & 3); }
struct Unit { int pm, pn; };
struct Gemm { const bf16_t* A; const bf16_t* Bt; int M, N, K; };
struct StaticOrder {
    int nN, mt, nun, x, rank, nloc;
    __device__ void init(int M_, int N_, int nx_, int nloc_, int x_, int rank_) { nN = N_ / BM; mt = (M_ / BM) / nx_; nun = mt * nN; x = x_; rank = rank_; nloc = nloc_; }
    __device__ bool next(int i, Unit& u) const {
        const int off = i * nloc + rank; if (off >= nun) return false;
        const int nig = WGM * nN, gid = off / nig, fm = gid * WGM, gsz = (mt - fm) < WGM ? (mt - fm) : WGM;
        u.pm = x * mt + fm + ((off % nig) % gsz); u.pn = (off % nig) / gsz; return true;
    }
};
typedef f32x4 Acc[2][2][4][2];

struct EpiSwiGLU {
    static constexpr bool FUSED = false;
    bf16_t* H;
    __device__ __forceinline__ void operator()(const Acc& acc, const Unit& u, int wr, int wc, int fr, int fq) const {
        const int row0 = u.pm * BM + wr * 64 + fr; const int col0 = u.pn * 128 + wc * 32 + 8 * fq;
#pragma unroll
        for (int ai = 0; ai < 2; ++ai)
#pragma unroll
            for (int m = 0; m < 4; ++m) {
                f32x4 h[2];
#pragma unroll
                for (int n = 0; n < 2; ++n)
#pragma unroll
                    for (int j = 0; j < 4; ++j) { const float g = acc[ai][0][m][n][j]; h[n][j] = g * sigmoidf_(g) * acc[ai][1][m][n][j]; }
                *(u32x4*)(H + (size_t)(row0 + ai * HALF + m * 16) * DFF + col0) = pack8u(h[0], h[1]);
            }
    }
};
struct EpiRowSS {
    static constexpr bool FUSED = true;
    bf16_t* F; float* ss; RowArgs R; unsigned* cnt; unsigned target;
    __device__ __forceinline__ void operator()(const Acc& acc, const Unit& u, int wr, int wc, int fr, int fq) const {
        const int row0 = u.pm * BM + wr * 64 + fr; const int col0 = u.pn * BM + wc * 32 + 8 * fq;
#pragma unroll
        for (int ai = 0; ai < 2; ++ai)
#pragma unroll
            for (int m = 0; m < 4; ++m) {
                const int row = row0 + ai * HALF + m * 16; float s = 0.f;
#pragma unroll
                for (int bj = 0; bj < 2; ++bj) { const f32x4 a = acc[ai][bj][m][0], b = acc[ai][bj][m][1];
                    s += (a[0] * a[0] + a[1] * a[1]) + (a[2] * a[2] + a[3] * a[3]) + (b[0] * b[0] + b[1] * b[1]) + (b[2] * b[2] + b[3] * b[3]);
                    *(u32x4*)(F + (size_t)row * DM + col0 + bj * HALF) = pack8u(a, b); }
                s += __shfl_xor(s, 16); s += __shfl_xor(s, 32);
                if (fq == 0) ss[(size_t)row * 32 + u.pn * 4 + wc] = s;
            }
    }
};
struct EpiHeads {
    static constexpr bool FUSED = false;
    bf16_t* O; size_t tstride; int nh_shift; int s_shift;
    __device__ __forceinline__ void operator()(const Acc& acc, const Unit& u, int wr, int wc, int fr, int fq) const {
        const int row0 = u.pm * BM + wr * 64 + fr; const int cw = wc * 32 + 8 * fq;
#pragma unroll
        for (int bj = 0; bj < 2; ++bj) { const int hidx = u.pn * 2 + bj, t = hidx >> nh_shift, head = hidx & ((1 << nh_shift) - 1);
            bf16_t* base = O + (size_t)t * tstride;
#pragma unroll
            for (int ai = 0; ai < 2; ++ai)
#pragma unroll
                for (int m = 0; m < 4; ++m) { const int row = row0 + ai * HALF + m * 16, b = row >> s_shift, s = row & ((1 << s_shift) - 1);
                    *(u32x4*)(base + ((((size_t)b << nh_shift) + head) << s_shift) * 128 + (size_t)s * 128 + cw) = pack8u(acc[ai][bj][m][0], acc[ai][bj][m][1]); } }
    }
};
struct EpiIn {
    static constexpr bool FUSED = false;
    bf16_t* QKV; size_t tstride; bf16_t* Z; bf16_t* WC; unsigned char* SA; float* LOGF; const float* gate_bias; const float* forget_bias; bf16_t* NRM;
    __device__ __forceinline__ void operator()(const Acc& acc, const Unit& u, int wr, int wc, int fr, int fq) const {
        const int pn = u.pn; const int row0 = u.pm * BM + wr * 64 + fr; const int cw = wc * 32 + 8 * fq;
        if (pn < 24) {
#pragma unroll
            for (int bj = 0; bj < 2; ++bj) { const int hidx = pn * 2 + bj, t = hidx >> 4, head = hidx & 15;
                bf16_t* base = QKV + (size_t)t * tstride;
#pragma unroll
                for (int ai = 0; ai < 2; ++ai)
#pragma unroll
                    for (int m = 0; m < 4; ++m) { const int row = row0 + ai * HALF + m * 16, b = row >> 11, s = row & 2047;
                        *(u32x4*)(base + ((size_t)(b * 16 + head) * SEQ + s) * 128 + cw) = pack8u(acc[ai][bj][m][0], acc[ai][bj][m][1]);
                        if (pn < 16) {
                            const f32x4 a = acc[ai][bj][m][0], c = acc[ai][bj][m][1];
                            float sq = (a[0] * a[0] + a[1] * a[1]) + (a[2] * a[2] + a[3] * a[3]) + (c[0] * c[0] + c[1] * c[1]) + (c[2] * c[2] + c[3] * c[3]);
                            sq += __shfl_xor(sq, 16); sq += __shfl_xor(sq, 32);
                            if (fq == 0) NRM[(size_t)t * ((size_t)M * 64) + ((size_t)row * 16 + head) * 4 + wc] = (bf16_t)(cvt_pk_bf16(sq * 1.02f, 0.f) & 0xffffu); } } }
        } else if (pn < 40) {
            const int cz = (pn - 24) * 128 + cw;
#pragma unroll
            for (int ai = 0; ai < 2; ++ai)
#pragma unroll
                for (int m = 0; m < 4; ++m) { const int row = row0 + ai * HALF + m * 16;
                    *(u32x4*)(Z + (size_t)row * DM + cz) = pack8u(acc[ai][0][m][0] * acc[ai][1][m][0], acc[ai][0][m][1] * acc[ai][1][m][1]); }
        } else if (pn < 56) {
            const int cz = (pn - 40) * 128 + cw;
            const f32x4 g0 = *(const f32x4*)(gate_bias + DM + cz), g1 = *(const f32x4*)(gate_bias + DM + cz + 4);
#pragma unroll
            for (int ai = 0; ai < 2; ++ai)
#pragma unroll
                for (int m = 0; m < 4; ++m) { const int row = row0 + ai * HALF + m * 16; f32x4 w0, w1;
#pragma unroll
                    for (int j = 0; j < 4; ++j) { w0[j] = acc[ai][0][m][0][j] * sigmoidf_(acc[ai][1][m][0][j] + g0[j]); w1[j] = acc[ai][0][m][1][j] * sigmoidf_(acc[ai][1][m][1][j] + g1[j]); }
                    *(u32x4*)(WC + (size_t)row * DM + cz) = pack8u(w0, w1); }
        } else if (pn < 64) {
#pragma unroll
            for (int bj = 0; bj < 2; ++bj) { const int cz = (pn - 56) * 256 + bj * HALF + cw;
                const f32x4 g0 = *(const f32x4*)(gate_bias + cz), g1 = *(const f32x4*)(gate_bias + cz + 4);
#pragma unroll
                for (int ai = 0; ai < 2; ++ai)
#pragma unroll
                    for (int m = 0; m < 4; ++m) { const int row = row0 + ai * HALF + m * 16; unsigned q0 = 0u, q1 = 0u;
#pragma unroll
                        for (int j = 0; j < 4; ++j) { q0 |= ((unsigned)(sigmoidf_(acc[ai][bj][m][0][j] + g0[j]) * 255.f + 0.5f)) << (8 * j); q1 |= ((unsigned)(sigmoidf_(acc[ai][bj][m][1][j] + g1[j]) * 255.f + 0.5f)) << (8 * j); }
                        u32x2 w; w.x = q0; w.y = q1; *(u32x2*)(SA + (size_t)row * DM + cz) = w; } }
        } else {
            if (wc == 0 && fq < 2) {
                const f32x4 fb0 = *(const f32x4*)(forget_bias + 8 * fq), fb1 = *(const f32x4*)(forget_bias + 8 * fq + 4);
#pragma unroll
                for (int ai = 0; ai < 2; ++ai)
#pragma unroll
                    for (int m = 0; m < 4; ++m) { const int row = row0 + ai * HALF + m * 16; f32x4 l0, l1;
#pragma unroll
                        for (int j = 0; j < 4; ++j) { const float x0 = acc[ai][0][m][0][j] + fb0[j], x1 = acc[ai][0][m][1][j] + fb1[j];
                            l0[j] = fminf(x0, 0.f) - log1pf(expf(-fabsf(x0))); l1[j] = fminf(x1, 0.f) - log1pf(expf(-fabsf(x1))); }
                        *(f32x4*)(LOGF + (size_t)row * 16 + 8 * fq) = l0; *(f32x4*)(LOGF + (size_t)row * 16 + 8 * fq + 4) = l1; }
            }
        }
    }
};

template <class Epi>
__device__ __forceinline__ void gemm_phase(LAS unsigned char* lds, const Gemm g, const StaticOrder& S, const Epi& E, const int tid) {
    const int wid = __builtin_amdgcn_readfirstlane(tid >> 6), lane = tid & 63, wr = wid >> 2, wc = wid & 3, fr = lane & 15, fq = lane >> 4;
    const int K = g.K, nt = K / BK;
    unsigned voffA[2], voffB[2];
#pragma unroll
    for (int i = 0; i < 2; ++i) { int R, C; stage_rc(tid * 16 + i * 8192, R, C); const int Rb = (R & ~31) + perm32(R & 31);
        voffA[i] = (unsigned)(R * K + C) * 2u; voffB[i] = (unsigned)(Rb * K + C) * 2u; }
    const size_t kstep = (size_t)(BK * 2);
    const size_t hstep = (size_t)HALF * K * 2;
    const size_t tstep = 2 * hstep;
    const unsigned ldsw = (unsigned)wid * 1024u;
    const int aoff = lds_byte(wr * 64 + fr, fq * 8), boff = lds_byte(wc * 32 + fr, fq * 8);
#define PG8_SA(b, h) (((b) * 2 + (h)) * HTB)
#define PG8_SB(b, h) ((4 + (b) * 2 + (h)) * HTB)
#define PG8_STAGE(bufoff, gbase, voff) do { _Pragma("unroll") for (int _i = 0; _i < 2; ++_i) \
        __builtin_amdgcn_global_load_lds((const unsigned*)((const char*)(gbase) + (voff)[_i]), (LAS unsigned*)(lds + (bufoff) + ldsw + _i * 8192), 16, 0, 0); } while (0)
#define PG8_LDA(dst, b, h) do { _Pragma("unroll") for (int m = 0; m < 4; ++m) _Pragma("unroll") for (int k = 0; k < 2; ++k) dst[m][k] = *(const LAS bf16x8*)(lds + PG8_SA(b, h) + aoff + m * 2048 + k * 1024); } while (0)
#define PG8_LDB(dst, b, h) do { _Pragma("unroll") for (int n = 0; n < 2; ++n) _Pragma("unroll") for (int k = 0; k < 2; ++k) dst[n][k] = *(const LAS bf16x8*)(lds + PG8_SB(b, h) + boff + n * 2048 + k * 1024); } while (0)
#define PG8_MMA(ai, bj, At, Bt) do { __builtin_amdgcn_s_setprio(1); _Pragma("unroll") for (int m = 0; m < 4; ++m) _Pragma("unroll") for (int n = 0; n < 2; ++n) _Pragma("unroll") for (int k = 0; k < 2; ++k) \
        acc[ai][bj][m][n] = __builtin_amdgcn_mfma_f32_16x16x32_bf16(Bt[n][k], At[m][k], acc[ai][bj][m][n], 0, 0, 0); __builtin_amdgcn_s_setprio(0); } while (0)
#define PG8_WAIT_V(n) asm volatile("s_waitcnt vmcnt(" #n ")" ::: "memory")
#define PG8_WAIT_L(n) asm volatile("s_waitcnt lgkmcnt(" #n ")" ::: "memory")
#define PG8_BAR __builtin_amdgcn_s_barrier()
#define PG8_SCHED __builtin_amdgcn_sched_barrier(0)
    Unit cur, nxt; int ui = 0;
    if (!S.next(0, cur)) return;
    Unit prev = cur; bool have_prev = false;
    f32x4 acc[2][2][4][2];
#pragma unroll
    for (int a = 0; a < 2; ++a)
#pragma unroll
        for (int b = 0; b < 2; ++b)
#pragma unroll
            for (int m = 0; m < 4; ++m)
#pragma unroll
                for (int n = 0; n < 2; ++n) acc[a][b][m][n] = (f32x4){0.f, 0.f, 0.f, 0.f};
    bf16x8 At[4][2], B0[2][2], B1[2][2];
    const char* cA = (const char*)g.A + (size_t)cur.pm * tstep; const char* cB = (const char*)g.Bt + (size_t)cur.pn * tstep;
    PG8_STAGE(PG8_SB(0, 0), cB, voffB); PG8_STAGE(PG8_SB(0, 1), cB + hstep, voffB); PG8_STAGE(PG8_SA(0, 0), cA, voffA); PG8_STAGE(PG8_SA(0, 1), cA + hstep, voffA);
    if (wr == 1) PG8_BAR;
    PG8_WAIT_V(2); PG8_BAR;
    PG8_STAGE(PG8_SB(1, 0), cB + kstep, voffB); PG8_STAGE(PG8_SA(1, 0), cA + kstep, voffA); PG8_STAGE(PG8_SB(1, 1), cB + hstep + kstep, voffB);
    PG8_WAIT_V(6); PG8_BAR;
    for (;;) {
        const bool has_next = S.next(ui + 1, nxt);
        const char* nA = has_next ? (const char*)g.A + (size_t)nxt.pm * tstep : cA; const char* nB = has_next ? (const char*)g.Bt + (size_t)nxt.pn * tstep : cB;
        for (int t = 0; t < nt; t += 2) {
            const bool last = (t == nt - 2);
            const char* a1 = cA + (size_t)(t + 1) * kstep;
            const char* a2 = last ? nA : cA + (size_t)(t + 2) * kstep; const char* b2 = last ? nB : cB + (size_t)(t + 2) * kstep;
            const char* a3 = a2 + kstep; const char* b3 = b2 + kstep;
            PG8_LDB(B0, 0, 0); PG8_LDB(B1, 0, 1); PG8_SCHED; PG8_LDA(At, 0, 0); PG8_STAGE(PG8_SA(1, 1), a1 + hstep, voffA);
            PG8_WAIT_V(8); PG8_WAIT_L(0); PG8_BAR; PG8_MMA(0, 0, At, B0); PG8_MMA(0, 1, At, B1); PG8_BAR; PG8_SCHED;
            PG8_LDA(At, 0, 1); PG8_STAGE(PG8_SB(0, 0), b2, voffB); PG8_STAGE(PG8_SB(0, 1), b2 + hstep, voffB); PG8_STAGE(PG8_SA(0, 0), a2, voffA);
            PG8_WAIT_V(8); PG8_WAIT_L(0); PG8_BAR; PG8_MMA(1, 0, At, B0); PG8_MMA(1, 1, At, B1); PG8_BAR; PG8_SCHED;
            PG8_LDB(B0, 1, 0); PG8_LDB(B1, 1, 1); PG8_SCHED; PG8_LDA(At, 1, 0); PG8_STAGE(PG8_SA(0, 1), a2 + hstep, voffA);
            PG8_WAIT_V(8); PG8_WAIT_L(0); PG8_BAR; PG8_MMA(0, 0, At, B0); PG8_MMA(0, 1, At, B1); PG8_BAR; PG8_SCHED;
            PG8_LDA(At, 1, 1); PG8_STAGE(PG8_SB(1, 0), b3, voffB); PG8_STAGE(PG8_SB(1, 1), b3 + hstep, voffB); PG8_STAGE(PG8_SA(1, 0), a3, voffA);
            PG8_WAIT_V(8); PG8_WAIT_L(0); PG8_BAR; PG8_MMA(1, 0, At, B0); PG8_MMA(1, 1, At, B1); PG8_BAR; PG8_SCHED;
        }
        if (wr == 0) PG8_BAR;
        E(acc, cur, wr, wc, fr, fq);
        if constexpr (Epi::FUSED) {
            asm volatile("s_waitcnt vmcnt(0)" ::: "memory");
            __builtin_amdgcn_s_barrier();
            if (tid == 0) {
                __hip_atomic_fetch_add(E.cnt + 64 * cur.pm, 1u, __ATOMIC_RELAXED, __HIP_MEMORY_SCOPE_AGENT);
                if (have_prev) { unsigned* c = E.cnt + 64 * prev.pm; unsigned sp = 0;
                    while (__hip_atomic_load(c, __ATOMIC_RELAXED, __HIP_MEMORY_SCOPE_AGENT) < E.target) { __builtin_amdgcn_s_sleep(1); if (++sp > (1u << 22)) break; }
                    __builtin_amdgcn_fence(__ATOMIC_ACQUIRE, "agent");
                    asm volatile("s_waitcnt vmcnt(0)" ::: "memory"); }
            }
            __builtin_amdgcn_s_barrier();
            asm volatile("" ::: "memory");
            if (have_prev) {
                int lane_f = lane; asm volatile("" : "+v"(lane_f));
#pragma unroll 1
                for (int r = wid; r < 32; r += 16) row_n<2>(E.R, E.F, E.ss, prev.pm * BM + prev.pn * 32 + r, 8, lane_f);
                asm volatile("s_waitcnt vmcnt(0)" ::: "memory");
            }
            prev = cur; have_prev = true;
        }
        if (!has_next) break;
#pragma unroll
        for (int a = 0; a < 2; ++a)
#pragma unroll
            for (int b = 0; b < 2; ++b)
#pragma unroll
                for (int m = 0; m < 4; ++m)
#pragma unroll
                    for (int n = 0; n < 2; ++n) acc[a][b][m][n] = (f32x4){0.f, 0.f, 0.f, 0.f};
        cur = nxt; cA = nA; cB = nB; ++ui;
        if (wr == 1) PG8_BAR;
    }
    PG8_WAIT_V(0);
    PG8_BAR;
    if constexpr (Epi::FUSED) {
        if (have_prev) {
            if (tid == 0) { unsigned* c = E.cnt + 64 * prev.pm; unsigned sp = 0;
                while (__hip_atomic_load(c, __ATOMIC_RELAXED, __HIP_MEMORY_SCOPE_AGENT) < E.target) { __builtin_amdgcn_s_sleep(1); if (++sp > (1u << 22)) break; }
                __builtin_amdgcn_fence(__ATOMIC_ACQUIRE, "agent");
                asm volatile("s_waitcnt vmcnt(0)" ::: "memory"); }
            __builtin_amdgcn_s_barrier();
            asm volatile("" ::: "memory");
            int lane_f = lane; asm volatile("" : "+v"(lane_f));
#pragma unroll 1
            for (int r = wid; r < 32; r += 16) row_n<2>(E.R, E.F, E.ss, prev.pm * BM + prev.pn * 32 + r, 8, lane_f);
        }
    }
#undef PG8_SA
#undef PG8_SB
#undef PG8_STAGE
#undef PG8_LDA
#undef PG8_LDB
#undef PG8_MMA
#undef PG8_WAIT_V
#undef PG8_WAIT_L
#undef PG8_BAR
#undef PG8_SCHED
}
}

namespace fa {
constexpr int D = 128, NW = 8, QBLK = 32, KVBLK = 64, QB = NW * QBLK;
constexpr int SHM_V = KVBLK * D * 2, SHM_K = KVBLK * D * 2;
constexpr int OFF_WS = 2 * SHM_V + 2 * SHM_K, OFF_KB = OFF_WS + NW * 64 * 4, OFF_OST = OFF_KB + 2 * 2048 * 4, OST_ROW = 136, LDS_BYTES = OFF_OST + NW * 32 * OST_ROW * 2;
constexpr float SCALE = 0.08838834764831845f, C2 = LOG2E * SCALE, THR2 = 8.f;
#define KSWZ(row, colB) ((row) * 256 + ((colB) ^ (((row) & 7) << 4)))
#define SBAR() __builtin_amdgcn_sched_barrier(0)
__device__ __forceinline__ int v_st(int k, int c) { const int kk = (k & ~0xC) | ((k & 4) << 1) | ((k & 8) >> 1); return ((kk >> 3) * 4 + (c >> 5)) * 512 + ((kk & 7) * 32 + (c & 31)) * 2; }
__device__ __forceinline__ int v_rd_base(int lane) { return ((lane & 3) << 3) | (((lane >> 2) & 3) << 6) | (((lane >> 4) & 1) << 5) | (((lane >> 5) & 1) << 8); }
constexpr int v_rd_off(int d0, int ks, int half) { return d0 * 512 + ks * 4096 + half * 2048; }
__device__ __forceinline__ int crow(int r, int hi) { return (r & 3) + 8 * (r >> 2) + 4 * hi; }
__device__ __forceinline__ bf16x8 load8(const bf16_t* p) { return *reinterpret_cast<const bf16x8*>(p); }
__device__ __forceinline__ void mask_tile(f32x16& p0, f32x16& p1, int dq, unsigned W) {
    const float NEG = -__builtin_inff();
#pragma unroll
    for (int r = 0; r < 16; ++r) {
        const int c = (r & 3) + 8 * (r >> 2);
        if ((unsigned)(dq - c) >= W) p0[r] = NEG;
        if ((unsigned)(dq - c - 32) >= W) p1[r] = NEG;
    }
}
__device__ __forceinline__ void partialSM(f32x16& p0, f32x16& p1, const float* kb, float& m_reg, float& mn, float& alpha) {
#pragma unroll
    for (int g = 0; g < 4; ++g) { const f32x4 b0 = *(const f32x4*)(kb + 8 * g), b1 = *(const f32x4*)(kb + 32 + 8 * g);
#pragma unroll
        for (int j = 0; j < 4; ++j) { p0[4 * g + j] = fmaf(p0[4 * g + j], C2, b0[j]); p1[4 * g + j] = fmaf(p1[4 * g + j], C2, b1[j]); } }
    float pmax = p0[0];
#pragma unroll
    for (int r = 1; r < 16; ++r) pmax = fmaxf(pmax, p0[r]);
#pragma unroll
    for (int r = 0; r < 16; ++r) pmax = fmaxf(pmax, p1[r]);
    { auto rr = __builtin_amdgcn_permlane32_swap(__float_as_uint(pmax), __float_as_uint(pmax), false, false);
      pmax = fmaxf(__uint_as_float(rr[0]), __uint_as_float(rr[1])); }
    if (__builtin_expect(__all((pmax - m_reg) <= THR2), 1)) { mn = m_reg; alpha = 1.f; }
    else { mn = fmaxf(m_reg, pmax); alpha = __builtin_amdgcn_exp2f(m_reg - mn); m_reg = mn; }
#pragma unroll
    for (int r = 0; r < 16; ++r) { p0[r] -= mn; p1[r] -= mn; }
#pragma unroll
    for (int r = 0; r < 16; ++r) p0[r] = __builtin_amdgcn_exp2f(p0[r]);
}
__device__ __forceinline__ void finishSM(f32x16& p0, f32x16& p1, float alpha, float& l_reg, bf16x8& pa0, bf16x8& pa1, bf16x8& pa2, bf16x8& pa3) {
#pragma unroll
    for (int r = 0; r < 16; ++r) p1[r] = __builtin_amdgcn_exp2f(p1[r]);
    float ps = 0;
#pragma unroll
    for (int r = 0; r < 16; ++r) ps += p0[r];
#pragma unroll
    for (int r = 0; r < 16; ++r) ps += p1[r];
    { auto rr = __builtin_amdgcn_permlane32_swap(__float_as_uint(ps), __float_as_uint(ps), false, false);
      ps = __uint_as_float(rr[0]) + __uint_as_float(rr[1]); }
    l_reg = l_reg * alpha + ps;
#define PK4(P, B_, OUT) do { unsigned a0 = cvt_pk_bf16(P[B_+0], P[B_+1]), a1 = cvt_pk_bf16(P[B_+2], P[B_+3]);                          \
        unsigned b0 = cvt_pk_bf16(P[B_+4], P[B_+5]), b1 = cvt_pk_bf16(P[B_+6], P[B_+7]);                                             \
        auto r0 = __builtin_amdgcn_permlane32_swap(a0, b0, false, false); auto r1 = __builtin_amdgcn_permlane32_swap(a1, b1, false, false); \
        u32x4 w = {r0[0], r1[0], r0[1], r1[1]}; OUT = *reinterpret_cast<bf16x8*>(&w); } while (0)
    PK4(p0, 0, pa0); PK4(p0, 8, pa1); PK4(p1, 0, pa2); PK4(p1, 8, pa3);
#undef PK4
}
template <int KB>
__device__ __forceinline__ void qkt(f32x16& p0, f32x16& p1, const char* K_lds, int r32, int hi, const bf16x8* qr) {
    p0 = f32x16{}; p1 = f32x16{};
    const char* kb[4];
#pragma unroll
    for (int dd = 0; dd < 4; ++dd) kb[dd] = K_lds + KB * SHM_K + KSWZ(r32, (dd * 16 + hi * 8) * 2);
    __builtin_amdgcn_s_setprio(1);
#pragma unroll
    for (int d0 = 0; d0 < 8; ++d0) { const char* a = kb[d0 & 3] + (d0 >> 2) * 128;
        bf16x8 b0 = *reinterpret_cast<const bf16x8*>(a);
        bf16x8 b1 = *reinterpret_cast<const bf16x8*>(a + 32 * 256);
        p0 = __builtin_amdgcn_mfma_f32_32x32x16_bf16(b0, qr[d0], p0, 0, 0, 0);
        p1 = __builtin_amdgcn_mfma_f32_32x32x16_bf16(b1, qr[d0], p1, 0, 0, 0); }
    __builtin_amdgcn_s_setprio(0);
}
template <int VB>
__device__ __forceinline__ void pv_tile(f32x16* o, int vb0, bf16x8 pa0, bf16x8 pa1, bf16x8 pa2, bf16x8 pa3) {
#define TRRD(dst, off) asm volatile("ds_read_b64_tr_b16 %0, %1 offset:%2" : "=&v"(dst) : "v"(vb0), "i"(off) : "memory")
#define PV_D0(d0) do { s16x4 l0, l1, l2, l3, h0, h1, h2, h3; constexpr int b_ = VB * SHM_V + v_rd_off(d0, 0, 0); \
        TRRD(l0, b_); TRRD(h0, b_ + 2048); TRRD(l1, b_ + 4096); TRRD(h1, b_ + 6144); TRRD(l2, b_ + 8192); TRRD(h2, b_ + 10240); TRRD(l3, b_ + 12288); TRRD(h3, b_ + 14336); \
        asm volatile("s_waitcnt lgkmcnt(0)" ::: "memory"); SBAR();   \
        o[d0] = __builtin_amdgcn_mfma_f32_32x32x16_bf16(pa0, (bf16x8){l0[0], l0[1], l0[2], l0[3], h0[0], h0[1], h0[2], h0[3]}, o[d0], 0, 0, 0);   \
        o[d0] = __builtin_amdgcn_mfma_f32_32x32x16_bf16(pa1, (bf16x8){l1[0], l1[1], l1[2], l1[3], h1[0], h1[1], h1[2], h1[3]}, o[d0], 0, 0, 0);   \
        o[d0] = __builtin_amdgcn_mfma_f32_32x32x16_bf16(pa2, (bf16x8){l2[0], l2[1], l2[2], l2[3], h2[0], h2[1], h2[2], h2[3]}, o[d0], 0, 0, 0);   \
        o[d0] = __builtin_amdgcn_mfma_f32_32x32x16_bf16(pa3, (bf16x8){l3[0], l3[1], l3[2], l3[3], h3[0], h3[1], h3[2], h3[3]}, o[d0], 0, 0, 0); } while (0)
    __builtin_amdgcn_s_setprio(1);
    PV_D0(0); PV_D0(1); PV_D0(2); PV_D0(3);
    __builtin_amdgcn_s_setprio(0);
#undef PV_D0
#undef TRRD
}
struct Blk { const bf16_t* Q; const bf16_t* K; const bf16_t* V; const float* KBg; size_t ooff; int P0; int col0; int jlo; };
struct Phase { int mode; int skv; int W; int pitch; bf16_t* O; const unsigned char* SA; const bf16_t* WC; const bf16_t* Z; const float* conv_w; const float* conv_b; };
struct Seam { bf16x8 qr[8]; bf16x8 st_v0, st_v1, st_k0, st_k1; };
__device__ __forceinline__ int swa_jlo(int P0, int W) { const int lowk = P0 - W + 1; return lowk > 0 ? lowk / KVBLK : 0; }
#define LDG8(base, byteoff) (*(const bf16x8*)((const char*)(base) + (size_t)(byteoff)))
#define VMW() asm volatile("s_waitcnt vmcnt(0)" ::: "memory")
#define VMWN(n) asm volatile("s_waitcnt vmcnt(%0)" :: "i"(n) : "memory")
#define SLOAD_H(Kp, Vp, k0) do { const char* vb_ = (const char*)(Vp) + (size_t)(k0) * (D * 2); const char* kb_ = (const char*)(Kp) + (size_t)(k0) * (D * 2); \
                         S.st_v0 = LDG8(vb_, soff); S.st_v1 = LDG8(vb_ + 32 * D * 2, soff); S.st_k0 = LDG8(kb_, soff); S.st_k1 = LDG8(kb_ + 32 * D * 2, soff); } while (0)
#define SWRITE_HK(bf) do { *(bf16x8*)(K_lds + (bf) * SHM_K + kws) = S.st_k0; *(bf16x8*)(K_lds + (bf) * SHM_K + kws + 32 * 256) = S.st_k1; } while (0)
#define SWRITE_HV(bf) do { *(bf16x8*)(V_lds + (bf) * SHM_V + vst0) = S.st_v0; *(bf16x8*)(V_lds + (bf) * SHM_V + vst1) = S.st_v1; } while (0)
#define SWRITE_H(bf) do { SWRITE_HV(bf); SWRITE_HK(bf); } while (0)
__device__ __forceinline__ void attn_prime(const Blk& cur, int W, char* lds, Seam& S, const int tid) {
    const int wid = __builtin_amdgcn_readfirstlane(tid >> 6), lane = tid & 63, r32 = lane & 31, hi = lane >> 5;
    const int sr = tid >> 4, sc = (tid & 15) * 8, kws = KSWZ(sr, sc * 2); char* K_lds = lds + 2 * SHM_V;
    const unsigned soff = (unsigned)(sr * D + sc) * 2u, qoff = (unsigned)(r32 * D + hi * 8) * 2u;
    const int kb0 = cur.jlo * KVBLK;
    { const char* qb_ = (const char*)cur.Q + (size_t)(wid * QBLK) * (D * 2);
#pragma unroll
    for (int d0 = 0; d0 < 8; ++d0) S.qr[d0] = LDG8(qb_ + d0 * 32, qoff); }
    f32x4 kbv = (f32x4){0.f, 0.f, 0.f, 0.f}; if (cur.KBg) kbv = *(const f32x4*)(cur.KBg + 4 * tid);
    SLOAD_H(cur.K, cur.V, kb0); VMW(); SWRITE_HK(0);
    *(f32x4*)(lds + OFF_KB + 16 * tid) = kbv;
    __syncthreads();
}
__device__ __forceinline__ void attn_block(const Blk& cur, const Blk& nxt, const Phase& P, char* lds, Seam& S, int par, const int tid) {
    const int wid = __builtin_amdgcn_readfirstlane(tid >> 6), lane = tid & 63, r32 = lane & 31, hi = lane >> 5;
    const int W = P.W, skv = P.skv;
    const int j_lo = cur.jlo;
    int j_hi = (cur.P0 + QB - 1) / KVBLK + 1; if (j_hi > skv / KVBLK) j_hi = skv / KVBLK;
    const int NT = j_hi - j_lo;
    const int kbn = nxt.jlo * KVBLK;
    const int qlo = cur.P0 + wid * QBLK, qm = qlo + r32 - 4 * hi;
    char* V_lds = lds; char* K_lds = lds + 2 * SHM_V;
    float* ws = (float*)(lds + OFF_WS) + wid * 64; float* li_l = ws, * al_l = ws + 32;
    const float* kbl = (const float*)(lds + OFF_KB + par * 8192) + 4 * hi;
    float m_reg = ((P.mode == 0) ? ((const float*)(lds + OFF_KB + par * 8192))[cur.P0 + wid * QBLK + r32] : 0.f) - 20.f, l_reg = 0; f32x16 o[4] = {};
    const int sr = tid >> 4, sc = (tid & 15) * 8, vst0 = v_st(sr, sc), vst1 = v_st(32 + sr, sc), kws = KSWZ(sr, sc * 2);
    const unsigned soff = (unsigned)(sr * D + sc) * 2u, qoff = (unsigned)(r32 * D + hi * 8) * 2u;
    const int vb0 = (int)(uintptr_t)V_lds + v_rd_base(lane);
    const bf16_t* Kh = cur.K; const bf16_t* Vh = cur.V;
#define RESC(a) do { if (__any((a) < 1.f)) { if (hi == 0) al_l[r32] = (a); asm volatile("s_waitcnt lgkmcnt(0)" ::: "memory");              \
                     for (int d_ = 0; d_ < 4; ++d_) for (int r = 0; r < 16; ++r) o[d_][r] *= al_l[crow(r, hi)]; } } while (0)
#define KBASE(t) ((j_lo + (t)) * KVBLK)
#define MASKT(P0_, P1_, t) do { const int kb_ = KBASE(t); if (kb_ + KVBLK - 1 > qlo || kb_ <= qlo + QBLK - 1 - W) mask_tile(P0_, P1_, qm - kb_, (unsigned)W); } while (0)
    constexpr int NQL = 8;
#define SEAM_K0() do { VMWN(NQL); SWRITE_HK(0); SBAR(); } while (0)
    f32x16 pA0, pA1, pB0, pB1; float mnA, mnB, alA, alB; bf16x8 pa0, pa1, pa2, pa3;
    SWRITE_HV(0); SBAR();
    if (NT > 1) { SLOAD_H(Kh, Vh, KBASE(1)); }
    SBAR(); qkt<0>(pA0, pA1, K_lds, r32, hi, S.qr);
    MASKT(pA0, pA1, 0); partialSM(pA0, pA1, kbl + KBASE(0), m_reg, mnA, alA);
    if (NT > 1) { VMW(); SWRITE_H(1); }
    __syncthreads();
#define HALF_STEP(PX0, PX1, mnX, alX, PY0, PY1, alY, t, KB, VB, SB) do {                                                      \
        SBAR(); qkt<KB>(PX0, PX1, K_lds, r32, hi, S.qr);                                             \
        finishSM(PY0, PY1, alY, l_reg, pa0, pa1, pa2, pa3); SBAR();                                                           \
        if ((t) + 1 < NT) { SLOAD_H(Kh, Vh, KBASE((t) + 1)); SBAR(); }                                               \
        pv_tile<VB>(o, vb0, pa0, pa1, pa2, pa3); MASKT(PX0, PX1, (t)); partialSM(PX0, PX1, kbl + KBASE(t), m_reg, mnX, alX);                                        \
        __syncthreads();                                                                                                      \
        if ((t) + 1 < NT) { VMW(); SWRITE_H(SB); }                                                                          \
        RESC(alX); __syncthreads(); } while (0)
    for (int t = 1; t + 1 < NT; t += 2) {
        HALF_STEP(pB0, pB1, mnB, alB, pA0, pA1, alA, t, 1, 0, 0);
        HALF_STEP(pA0, pA1, mnA, alA, pB0, pB1, alB, t + 1, 0, 1, 1);
    }
    const bool even = (NT & 1) == 0;
    if (even) { SBAR(); qkt<1>(pB0, pB1, K_lds, r32, hi, S.qr); SBAR(); }
    SLOAD_H(nxt.K, nxt.V, kbn); SBAR();
    { const char* qb_ = (const char*)nxt.Q + (size_t)(wid * QBLK) * (D * 2);
#pragma unroll
    for (int d0 = 0; d0 < 8; ++d0) S.qr[d0] = LDG8(qb_ + d0 * 32, qoff); }
    SBAR();
    finishSM(pA0, pA1, alA, l_reg, pa0, pa1, pa2, pa3); SBAR();
    pv_tile<0>(o, vb0, pa0, pa1, pa2, pa3);
    if (even) { MASKT(pB0, pB1, NT - 1); partialSM(pB0, pB1, kbl + KBASE(NT - 1), m_reg, mnB, alB); __syncthreads(); RESC(alB);
        finishSM(pB0, pB1, alB, l_reg, pa0, pa1, pa2, pa3); SBAR(); pv_tile<1>(o, vb0, pa0, pa1, pa2, pa3); }
    SBAR(); SEAM_K0();
    f32x4 kbv = (f32x4){0.f, 0.f, 0.f, 0.f}; if (nxt.KBg) kbv = *(const f32x4*)(nxt.KBg + 4 * tid);
    if (hi == 0) li_l[r32] = l_reg; asm volatile("s_waitcnt lgkmcnt(0)" ::: "memory");
    float rli[16];
#pragma unroll
    for (int r = 0; r < 16; ++r) rli[r] = __builtin_amdgcn_rcpf(li_l[crow(r, hi)]);
    const int pitch = P.pitch;
    {
        unsigned short* stg = (unsigned short*)(lds + OFF_OST) + wid * (32 * OST_ROW);
#pragma unroll
        for (int r = 0; r < 16; ++r) { const int orow = crow(r, hi);
#pragma unroll
            for (int d0 = 0; d0 < 4; ++d0) { const float v = o[d0][r] * rli[r]; stg[orow * OST_ROW + d0 * 32 + r32] = (unsigned short)(cvt_pk_bf16(v, v) & 0xffffu); } }
        asm volatile("s_waitcnt lgkmcnt(0)" ::: "memory");
        int lane_e = lane; asm volatile("" : "+v"(lane_e));
        const int ch = (lane_e & 15) * 8, rsub = lane_e >> 4;
        if (P.mode == 0) {
            const float* cwp = P.conv_w + cur.col0 + ch; const float* cbp = P.conv_b + cur.col0 + ch;
            const f32x4 w0a = *(const f32x4*)(cwp), w0b = *(const f32x4*)(cwp + 4), w1a = *(const f32x4*)(cwp + DM), w1b = *(const f32x4*)(cwp + DM + 4);
            const f32x4 w2a = *(const f32x4*)(cwp + 2 * DM), w2b = *(const f32x4*)(cwp + 2 * DM + 4), cba = *(const f32x4*)(cbp), cbq = *(const f32x4*)(cbp + 4);
#pragma unroll 2
            for (int p = 0; p < 8; ++p) {
                const int row = p * 4 + rsub, grow = wid * QBLK + row, sp = cur.P0 + grow;
                const size_t idx = cur.ooff + (size_t)grow * DM + ch;
                const u32x4 ov = *(const u32x4*)(stg + row * OST_ROW + ch);
                const u32x4 wcv = *(const u32x4*)(P.WC + idx); const u32x2 sav = *(const u32x2*)(P.SA + idx);
                const u32x4 z0 = *(const u32x4*)(P.Z + idx);
                u32x4 z1 = (u32x4){0u, 0u, 0u, 0u}, z2 = (u32x4){0u, 0u, 0u, 0u};
                if (sp >= 1) z1 = *(const u32x4*)(P.Z + idx - DM);
                if (sp >= 2) z2 = *(const u32x4*)(P.Z + idx - 2 * DM);
                u32x4 res;
#pragma unroll
                for (int e2 = 0; e2 < 4; ++e2) {
                    const float o0 = bf_lo(ov[e2]), o1 = bf_hi(ov[e2]), c0 = bf_lo(wcv[e2]), c1 = bf_hi(wcv[e2]);
                    const float a0 = bf_lo(z0[e2]), a1 = bf_hi(z0[e2]), b0 = bf_lo(z1[e2]), b1 = bf_hi(z1[e2]), d0_ = bf_lo(z2[e2]), d1_ = bf_hi(z2[e2]);
                    const unsigned sw = (e2 < 2) ? sav.x : sav.y; const int sh = (e2 & 1) * 16;
                    const float s0 = (float)((sw >> sh) & 0xffu) * (1.0f / 255.0f), s1 = (float)((sw >> (sh + 8)) & 0xffu) * (1.0f / 255.0f);
                    const int e = 2 * e2;
                    const float k0w0 = (e < 4) ? w0a[e & 3] : w0b[e & 3], k0w1 = (e < 4) ? w1a[e & 3] : w1b[e & 3], k0w2 = (e < 4) ? w2a[e & 3] : w2b[e & 3], k0b = (e < 4) ? cba[e & 3] : cbq[e & 3];
                    const float k1w0 = (e < 4) ? w0a[(e + 1) & 3] : w0b[(e + 1) & 3], k1w1 = (e < 4) ? w1a[(e + 1) & 3] : w1b[(e + 1) & 3], k1w2 = (e < 4) ? w2a[(e + 1) & 3] : w2b[(e + 1) & 3], k1b = (e < 4) ? cba[(e + 1) & 3] : cbq[(e + 1) & 3];
                    const float m0 = s0 * o0 + c0 * (k0b + k0w0 * d0_ + k0w1 * b0 + k0w2 * a0);
                    const float m1 = s1 * o1 + c1 * (k1b + k1w0 * d1_ + k1w1 * b1 + k1w2 * a1);
                    res[e2] = cvt_pk_bf16(m0, m1);
                }
                *(u32x4*)(P.O + idx) = res;
            }
        } else {
#pragma unroll
            for (int p = 0; p < 8; ++p) { const int row = p * 4 + rsub;
                *(u32x4*)(P.O + cur.ooff + (size_t)(wid * QBLK + row) * pitch + ch) = *(const u32x4*)(stg + row * OST_ROW + ch); }
        }
    }
    *(f32x4*)(lds + OFF_KB + (par ^ 1) * 8192 + 16 * tid) = kbv;
    __syncthreads();
#undef RESC
#undef KBASE
#undef MASKT
#undef SEAM_K0
#undef HALF_STEP
}
#undef LDG8
#undef VMW
#undef VMWN
#undef SLOAD_H
#undef SWRITE_HK
#undef SWRITE_HV
#undef SWRITE_H
}

constexpr int NWAVES = 8, NTHREADS = NWAVES * 64;
constexpr int LDS_BYTES = 163840;
static_assert(fa::LDS_BYTES <= LDS_BYTES - 64, "attention LDS");

struct Args { const float* in[24]; float* out; unsigned char* ws; };

__device__ __forceinline__ void transpose_item(const float* W, int ldw, int src_col0, int nvalid, bf16_t* WT, int K, int dest_row0, int k0, LAS float* scr, int lane) {
#pragma unroll
    for (int i = 0; i < 32; ++i) { const int kk = 2 * i + (lane >> 5), c = lane & 31; scr[kk * 33 + c] = (c < nvalid) ? W[(size_t)(k0 + kk) * ldw + src_col0 + c] : 0.f; }
    asm volatile("s_waitcnt lgkmcnt(0)" ::: "memory");
    const int c8 = lane & 7;
#pragma unroll
    for (int j = 0; j < 4; ++j) { const int n = (lane >> 3) + 8 * j; const LAS float* s = scr + (8 * c8) * 33 + n;
        u32x4 o; o.x = cvt_pk_bf16(s[0 * 33], s[1 * 33]); o.y = cvt_pk_bf16(s[2 * 33], s[3 * 33]); o.z = cvt_pk_bf16(s[4 * 33], s[5 * 33]); o.w = cvt_pk_bf16(s[6 * 33], s[7 * 33]);
        *(u32x4*)(WT + (size_t)(dest_row0 + n) * K + k0 + 8 * c8) = o; }
    asm volatile("s_waitcnt lgkmcnt(0)" ::: "memory");
}
__device__ __forceinline__ void conv_matrix(int kind, const float* W, int K, int ldw, int ndb, bf16_t* WT, LAS float* scr, int gw, int ngw, int lane) {
    const int nkb = K / 64; const int nitems = ndb * nkb;
    for (int it = gw; it < nitems; it += ngw) {
        const int db = it / nkb, kb = it - db * nkb; int src = 32 * db, nv = 32;
        if (kind == 1) { const int pn = db >> 3, r = db & 7; src = (r >> 2) * DFF + 128 * pn + (r & 3) * 32; }
        else if (kind == 2) { const int pn = db >> 3, r = db & 7, bj = r >> 2, c0 = (r & 3) * 32;
            if (pn < 24) src = 256 * pn + 32 * r;
            else if (pn < 40) src = (bj ? CC0 : CX0) + 128 * (pn - 24) + c0;
            else if (pn < 56) src = (bj ? GB0 : CB0) + 128 * (pn - 40) + c0;
            else if (pn < 64) src = GA0 + 256 * (pn - 56) + 32 * r;
            else { src = FL0; nv = (r == 0) ? 16 : 0; } }
        transpose_item(W, ldw, src, nv, WT, K, 32 * db, 64 * kb, scr, lane);
    }
}
__device__ __forceinline__ void row_phase(const RowArgs& R, int nrows, int nx, int nloc, int xcd, int rank, int wave, int lane) {
    const int rpx = nrows / nx, st = nloc * NWAVES;
    int lr = rank * NWAVES + wave;
    for (; lr + 3 * st < rpx; lr += 4 * st) rowU_n<4>(R.hin32, R.gpre, R.U, xcd * rpx + lr, st, lane);
    for (; lr < rpx; lr += st) rowU_n<1>(R.hin32, R.gpre, R.U, xcd * rpx + lr, st, lane);
}

typedef __attribute__((address_space(1))) unsigned gu32;
#define XB_TMO      128
#define XB_XCNT(j)  (256  + 64 * (j))
#define XB_XSUB(j)  (1280 + 64 * (j))
#define XB_XGEN(j)  (2304 + 64 * (j))
#define XB_TOP      3328
#define XB_TOPGEN   3392
#define XCD_BAR_WORDS 3456
#define XB_SPIN_CAP (1u << 18)

__device__ __forceinline__ unsigned xb_ld(unsigned* p)              { return __hip_atomic_load(p, __ATOMIC_RELAXED, __HIP_MEMORY_SCOPE_AGENT); }
__device__ __forceinline__ unsigned xb_add(unsigned* p, unsigned v) { return __hip_atomic_fetch_add(p, v, __ATOMIC_RELAXED, __HIP_MEMORY_SCOPE_AGENT); }
__device__ __forceinline__ unsigned xb_xcc_id() { return (unsigned)__builtin_amdgcn_s_getreg((3 << 11) | 20) & 0xFu; }
#define XB_SPIN(cond, bar) do { unsigned _sp = 0; while (cond) { __builtin_amdgcn_s_sleep(1); \
    if ((++_sp & 255u) == 0u) { if (xb_ld(&(bar)[XB_TMO])) break; if (_sp > XB_SPIN_CAP) { atomicAdd(&(bar)[XB_TMO], 1u); break; } } } } while (0)

struct XcdBarrier {
    unsigned* bar; unsigned x;
    volatile LAS unsigned* st;
};

__device__ __forceinline__ XcdBarrier xcd_barrier_post(unsigned* bar, volatile LAS unsigned* st) {
    XcdBarrier b; b.bar = bar; b.x = xb_xcc_id(); b.st = st;
    if (threadIdx.x == 0) (void)xb_add(&bar[XB_XCNT(b.x)], 1u);
    return b;
}
__device__ __forceinline__ void xcd_barrier_complete(unsigned* bar, unsigned x, unsigned& nloc, unsigned& nx) {
    const unsigned G = gridDim.x * gridDim.y * gridDim.z;
    unsigned sum, cnt, mine, sp = 0u;
    for (;;) {
        sum = 0u; cnt = 0u; mine = 0u;
#pragma unroll
        for (unsigned j = 0; j < 16; ++j) { const unsigned c = xb_ld(&bar[XB_XCNT(j)]); sum += c; cnt += (c > 0u) ? 1u : 0u; mine = (j == x) ? c : mine; }
        if (sum == G) break;
        __builtin_amdgcn_s_sleep(1);
        if ((++sp & 255u) == 0u) { if (xb_ld(&bar[XB_TMO])) break; if (sp > XB_SPIN_CAP) { atomicAdd(&bar[XB_TMO], 1u); break; } }
    }
    nloc = mine > 0u ? mine : 1u; nx = cnt > 0u ? cnt : 1u;
}

__device__ __forceinline__ void xcd_barrier(const XcdBarrier& b) {
    asm volatile("s_waitcnt vmcnt(0)" ::: "memory");
    __syncthreads();
    if (threadIdx.x == 0) {
        unsigned* bar = b.bar;
        __builtin_amdgcn_s_waitcnt(0);
        unsigned nloc = b.st[0], nx = b.st[1];
        if (nloc == 0u) { xcd_barrier_complete(bar, b.x, nloc, nx); b.st[0] = nloc; b.st[1] = nx; }
        const unsigned old = xb_add(&bar[XB_XSUB(b.x)], 1u);
        const unsigned gen = old / nloc;
        if (old + 1u == (gen + 1u) * nloc) {
            __builtin_amdgcn_fence(__ATOMIC_RELEASE, "");
            asm volatile("s_waitcnt vmcnt(0)" ::: "memory");
            const unsigned og = xb_add(&bar[XB_TOP], 1u);
            const unsigned tg = og / nx;
            if (og + 1u == (tg + 1u) * nx) xb_add(&bar[XB_TOPGEN], 1u);
            else XB_SPIN(xb_ld(&bar[XB_TOPGEN]) == tg, bar);
            __builtin_amdgcn_fence(__ATOMIC_ACQUIRE, "");
            xb_add(&bar[XB_XGEN(b.x)], 1u);
            asm volatile("s_waitcnt vmcnt(0)" ::: "memory");
        } else {
            XB_SPIN(xb_ld(&bar[XB_XGEN(b.x)]) == gen, bar);
            __builtin_amdgcn_fence(__ATOMIC_ACQUIRE, "");
            asm volatile("s_waitcnt vmcnt(0)" ::: "memory");
        }
    }
    __syncthreads();
}

enum { F_PREP = 1, F_CUMSUM = 2, F_GEMM = 4, F_ROW = 8, F_ROWU = 16, F_ATTN = 64 };
enum { E_SWIGLU = 0, E_ROWSS, E_IN, E_HEADS };

__device__ __forceinline__ bool attn_getblk(int sub, int k, int nx, int nloc, int xcd, int rank, unsigned char* ws, fa::Blk& B) {
    if (sub == 0) { const int per = (BATCH * NH) / nx, l = rank + (k >> 3) * nloc; if (l >= per) return false;
        const int bh = xcd * per + l, qb = 7 - (k & 7), b = bh >> 4, h = bh & 15;
        B.Q = (const bf16_t*)(ws + WS_QH) + ((size_t)bh * SEQ + qb * 256) * 128; B.K = (const bf16_t*)(ws + WS_KH) + (size_t)bh * SEQ * 128; B.V = (const bf16_t*)(ws + WS_VH) + (size_t)bh * SEQ * 128;
        B.KBg = (const float*)(ws + WS_KB) + (size_t)bh * SEQ; B.P0 = qb * 256; B.col0 = h * 128; B.ooff = ((size_t)b * SEQ + qb * 256) * DM + h * 128;
        B.jlo = ((const int*)(ws + WS_CTL))[CW_JLO + bh * 8 + qb]; return true; }
    else { const int per = (BATCH * MH * 8) / nx, l = rank + k * nloc; if (l >= per) return false;
        const int L = xcd * per + l;
        const int bh = L >> 3, qb = L & 7, b = bh >> 2, h = bh & 3;
        B.Q = (const bf16_t*)(ws + WS_QM) + ((size_t)bh * SEQ + qb * 256) * 128; B.K = (const bf16_t*)(ws + WS_KM) + (size_t)bh * NMEM * 128; B.V = (const bf16_t*)(ws + WS_VM) + (size_t)bh * NMEM * 128;
        B.KBg = nullptr; B.P0 = 4096; B.col0 = h * 128; B.ooff = ((size_t)b * SEQ + qb * 256) * MW + h * 128; B.jlo = 0; return true; }
}

constexpr int LDS_MISC = LDS_BYTES - 64;

__global__ void __launch_bounds__(NTHREADS, 2) fwd_megakernel(Args args) {
    extern __shared__ __attribute__((aligned(16))) unsigned char lds[];
    cg::grid_group grid = cg::this_grid();
    {
        volatile LAS unsigned* st0 = (volatile LAS unsigned*)((LAS unsigned char*)lds + LDS_MISC);
        unsigned* ctl = (unsigned*)(args.ws + WS_CTL);
        if (threadIdx.x == 0) { st0[0] = 0u; st0[1] = 0u; const unsigned x = xb_xcc_id(); st0[2] = x; st0[3] = xb_add(&ctl[CW_RANK + 64 * (x & 15u)], 1u); }
        __syncthreads();
        (void)xcd_barrier_post(ctl, st0);
        grid.sync();
        if (threadIdx.x == 0) {
            const unsigned G = gridDim.x; bool ok = (G % 8u) == 0u;
            for (unsigned j = 0; j < 16; ++j) { const unsigned c = xb_ld(&ctl[CW_RANK + 64 * j]); if (c != (j < 8 ? G / 8u : 0u)) ok = false; }
            if (ok) { st0[4] = 8u; st0[5] = G / 8u; } else { st0[2] = 0u; st0[3] = blockIdx.x; st0[4] = 1u; st0[5] = G; }
        }
        __syncthreads();
    }
#ifdef REPEAT_PH
    int rep_done = 0;
#endif
#pragma nounroll
    for (int ph = 0; ph <= LAST_PHASE; ++ph) {
        size_t wz = 0; asm volatile("" : "+s"(wz));
        unsigned char* ws = args.ws + wz;
        bf16_t* ubuf = (bf16_t*)(args.out + wz);
        int tid = threadIdx.x; asm volatile("" : "+v"(tid));
        int zz = 0; asm volatile("" : "+s"(zz));
#define IN(i) (args.in[(i) + zz])
        const int lane = tid & 63, wave = __builtin_amdgcn_readfirstlane(tid >> 6);
        LAS unsigned char* ldsl = (LAS unsigned char*)lds;
        unsigned moff = LDS_MISC; asm volatile("" : "+s"(moff));
        volatile LAS unsigned* misc = (volatile LAS unsigned*)(ldsl + moff);
        const int xcd = __builtin_amdgcn_readfirstlane((int)misc[2]), rank = __builtin_amdgcn_readfirstlane((int)misc[3]);
        const int nx = __builtin_amdgcn_readfirstlane((int)misc[4]), nloc = __builtin_amdgcn_readfirstlane((int)misc[5]);
        unsigned flags = 0; size_t offA = 0, offB = 0; int gM = M, gN = 0, gK = 0, epi = 0;
        int i_gpost = 0, i_gpre = 0, hin_x = 0, sub = 0; float r_alpha = 1.f;
        switch (ph) {
            case 0: flags = F_PREP; break;
            case 1: flags = F_GEMM; offA = WS_X0; offB = WS_W13A; gN = 2 * DFF; gK = DM; epi = E_SWIGLU; break;
            case 2: flags = F_GEMM | F_ROWU; offA = WS_HID; offB = WS_W2A; gN = DM; gK = DFF; epi = E_ROWSS; hin_x = 1; r_alpha = 0.5f; i_gpost = 5; i_gpre = 6; sub = 1; break;
            case 3: flags = F_GEMM; offA = WS_X0; offB = WS_WIN; gN = NIN; gK = DM; epi = E_IN; break;
            case 4: flags = F_CUMSUM; break;
            case 5: flags = F_ATTN; sub = 0; break;
            case 6: flags = F_GEMM | F_ROWU; offA = WS_X0; offB = WS_WOUT; gN = DM; gK = DM; epi = E_ROWSS; r_alpha = 1.f; i_gpost = 13; i_gpre = 14; sub = 2; break;
            case 7: flags = F_GEMM; offA = WS_X0; offB = WS_WMQ; gN = MW; gK = DM; epi = E_HEADS; sub = 0; break;
            case 8: flags = F_ATTN; sub = 1; break;
            case 9: flags = F_GEMM | F_ROWU; offA = WS_OM; offB = WS_WMO; gN = DM; gK = MW; epi = E_ROWSS; r_alpha = 1.f; i_gpost = 19; i_gpre = 20; sub = 3; break;
            case 10: flags = F_GEMM; offA = WS_X0; offB = WS_W13B; gN = 2 * DFF; gK = DM; epi = E_SWIGLU; break;
            default: flags = F_GEMM; offA = WS_HID; offB = WS_W2B; gN = DM; gK = DFF; epi = E_ROWSS; r_alpha = 0.5f; i_gpost = 23; i_gpre = 23; sub = 4; break;
        }
        if (flags & F_PREP) {
            const int gw = (xcd * nloc + rank) * NWAVES + wave, ngw = nx * nloc * NWAVES;
            LAS float* scr = (LAS float*)(ldsl + wave * 16384);
            conv_matrix(0, IN(22), DFF, DM, DM / 32, (bf16_t*)(ws + WS_W2B), scr, gw, ngw, lane);
            conv_matrix(1, IN(21), DM, 2 * DFF, (2 * DFF) / 32, (bf16_t*)(ws + WS_W13B), scr, gw, ngw, lane);
            conv_matrix(0, IN(18), MW, DM, DM / 32, (bf16_t*)(ws + WS_WMO), scr, gw, ngw, lane);
            conv_matrix(0, IN(17), DM, 2 * MW, (2 * MW) / 32, (bf16_t*)(ws + WS_WMKV), scr, gw, ngw, lane);
            conv_matrix(0, IN(16), DM, MW, MW / 32, (bf16_t*)(ws + WS_WMQ), scr, gw, ngw, lane);
            conv_matrix(0, IN(12), DM, DM, DM / 32, (bf16_t*)(ws + WS_WOUT), scr, gw, ngw, lane);
            conv_matrix(2, IN(7), DM, WIN_COLS, NIN / 32, (bf16_t*)(ws + WS_WIN), scr, gw, ngw, lane);
            conv_matrix(0, IN(4), DFF, DM, DM / 32, (bf16_t*)(ws + WS_W2A), scr, gw, ngw, lane);
            conv_matrix(1, IN(3), DM, 2 * DFF, (2 * DFF) / 32, (bf16_t*)(ws + WS_W13A), scr, gw, ngw, lane);
            { RowArgs R{IN(0), ubuf, nullptr, nullptr, nullptr, IN(2), ubuf, 1.f}; row_phase(R, M, nx, nloc, xcd, rank, wave, lane); }
            { RowArgs R{IN(1), ubuf, nullptr, nullptr, nullptr, IN(15), (bf16_t*)(ws + WS_MEMN), 1.f}; row_phase(R, MMEM, nx, nloc, xcd, rank, wave, lane); }
        }
        if (flags & F_CUMSUM) {
            LAS float* wtot = (LAS float*)ldsl;
            LAS float* kbs = (LAS float*)(ldsl + 1024);
            const float* LOGF = (const float*)(ws + WS_LOGF); float* KB = (float*)(ws + WS_KB);
            const int per = (BATCH * NH) / nx;
            for (int li = rank; li < per; li += nloc) {
                const int bh = xcd * per + li;
                const int b = bh >> 4, h = bh & 15;
                float v[4];
#pragma unroll
                for (int j = 0; j < 4; ++j) v[j] = LOGF[((size_t)b * SEQ + 4 * tid + j) * 16 + h];
                v[1] += v[0]; v[2] += v[1]; v[3] += v[2];
                float inc = v[3];
#pragma unroll
                for (int o = 1; o < 64; o <<= 1) { const float t = __shfl_up(inc, o); if (lane >= o) inc += t; }
                float qn = 0.f, kn = 0.f;
                {
                    const bf16_t* nq = (const bf16_t*)(ws + WS_NRM); const bf16_t* nk = nq + (size_t)M * 64;
#pragma unroll
                    for (int r = 0; r < 4; ++r) { const size_t o_ = (((size_t)b * SEQ + 4 * tid + r) * 16 + h) * 4;
                        const u32x2 a = *(const u32x2*)(nq + o_), k2v = *(const u32x2*)(nk + o_);
                        qn = fmaxf(qn, (bf_lo(a.x) + bf_hi(a.x)) + (bf_lo(a.y) + bf_hi(a.y))); kn = fmaxf(kn, (bf_lo(k2v.x) + bf_hi(k2v.x)) + (bf_lo(k2v.y) + bf_hi(k2v.y))); }
                }
#pragma unroll
                for (int o = 1; o < 64; o <<= 1) { qn = fmaxf(qn, __shfl_xor(qn, o)); kn = fmaxf(kn, __shfl_xor(kn, o)); }
                if (lane == 63) { wtot[wave] = inc; wtot[8 + wave] = qn; wtot[16 + wave] = kn; }
                __syncthreads();
                float pre = inc - v[3];
                for (int w = 0; w < wave; ++w) pre += wtot[w];
                f32x4 o4;
#pragma unroll
                for (int j = 0; j < 4; ++j) o4[j] = -(pre + v[j]) * LOG2E;
                *(f32x4*)(KB + (size_t)bh * SEQ + 4 * tid) = o4;
                *(LAS f32x4*)(kbs + 4 * tid) = o4;
                __syncthreads();
                if (tid < 8) {
                    float q2 = wtot[8 + tid], k2 = 0.f;
                    for (int w = 0; w <= tid; ++w) k2 = fmaxf(k2, wtot[16 + w]);
                    const float T = 2.0f * sqrtf(q2 * k2) * fa::C2 * 1.001f + 40.0f;
                    const int P0 = tid * 256; int j = P0 / 64; const float kb0 = kbs[P0];
                    while (j > 0 && !(kb0 - kbs[64 * j - 1] > T)) --j;
                    ((int*)(ws + WS_CTL))[CW_JLO + bh * 8 + tid] = j;
                }
                __syncthreads();
            }
        }
        if (flags & F_GEMM) {
            const int npass = (ph == 3) ? 2 : 1;
#pragma nounroll
            for (int pass = 0; pass < npass; ++pass) {
                int rk = rank;
                if (pass == 1) {
                    offA = WS_MEMN; offB = WS_WMKV; gM = MMEM; gN = 2 * MW; gK = DM; epi = E_HEADS; sub = 1; rk = (rank + nloc / 2) % nloc; }
                pg8::Gemm g{(offA == WS_X0) ? (const bf16_t*)ubuf : (const bf16_t*)(ws + offA), (const bf16_t*)(ws + offB), gM, gN, gK}; pg8::StaticOrder S; S.init(gM, gN, nx, nloc, xcd, rk);
                switch (epi) {
                    case E_SWIGLU: { pg8::EpiSwiGLU E{(bf16_t*)(ws + WS_HID)}; pg8::gemm_phase<pg8::EpiSwiGLU>(ldsl, g, S, E, tid); } break;
                    case E_ROWSS: { bf16_t* HB = (bf16_t*)(ws + WS_X0); const bool fin = !(flags & F_ROWU);
                        RowArgs R{hin_x ? IN(0) : (const float*)nullptr, HB, HB, fin ? (args.out + wz) : (float*)nullptr, IN(i_gpost), IN(i_gpre), fin ? (bf16_t*)nullptr : ubuf, r_alpha};
                        pg8::EpiRowSS E{(bf16_t*)(ws + WS_X1), (float*)(ws + WS_SS), R, (unsigned*)(ws + WS_CTL) + CW_PANEL, 8u * (unsigned)sub};
                        pg8::gemm_phase<pg8::EpiRowSS>(ldsl, g, S, E, tid); } break;
                    case E_IN: { pg8::EpiIn E{(bf16_t*)(ws + WS_QH), (size_t)(WS_KH - WS_QH) / 2, (bf16_t*)(ws + WS_Z), (bf16_t*)(ws + WS_WC), (unsigned char*)(ws + WS_SA), (float*)(ws + WS_LOGF), IN(9), IN(8), (bf16_t*)(ws + WS_NRM)};
                                 pg8::gemm_phase<pg8::EpiIn>(ldsl, g, S, E, tid); } break;
                    default: { pg8::EpiHeads E{(bf16_t*)(ws + (sub ? WS_KM : WS_QM)), (size_t)(WS_VM - WS_KM) / 2, 2, sub ? 8 : 11}; pg8::gemm_phase<pg8::EpiHeads>(ldsl, g, S, E, tid); } break;
                }
            }
        }
        if (flags & F_ATTN) {
            fa::Phase P;
            if (sub == 0) { P.mode = 0; P.skv = SEQ; P.W = 1 << 24; P.pitch = DM; P.O = ubuf; P.SA = (const unsigned char*)(ws + WS_SA); P.WC = (const bf16_t*)(ws + WS_WC); P.Z = (const bf16_t*)(ws + WS_Z); P.conv_w = IN(10); P.conv_b = IN(11); }
            else { P.mode = 1; P.skv = NMEM; P.W = 1 << 24; P.pitch = MW; P.O = (bf16_t*)(ws + WS_OM); P.SA = nullptr; P.WC = nullptr; P.Z = nullptr; P.conv_w = nullptr; P.conv_b = nullptr; }
            fa::Blk cur, nxt; fa::Seam S;
            if (attn_getblk(sub, 0, nx, nloc, xcd, rank, ws, cur)) {
                fa::attn_prime(cur, P.W, (char*)lds, S, tid);
                for (int k = 0;; ++k) {
                    const bool has = attn_getblk(sub, k + 1, nx, nloc, xcd, rank, ws, nxt); if (!has) nxt = cur;
                    fa::attn_block(cur, nxt, P, (char*)lds, S, k & 1, tid);
                    if (!has) break;
                    cur = nxt;
                }
            }
        }
        if (ph < LAST_PHASE) { XcdBarrier b_; b_.bar = (unsigned*)(ws + WS_CTL); b_.x = xb_xcc_id(); unsigned mo2 = LDS_MISC; asm volatile("" : "+s"(mo2)); b_.st = (volatile LAS unsigned*)(ldsl + mo2); xcd_barrier(b_); }
#ifdef REPEAT_PH
        if (ph == REPEAT_PH && !rep_done) { rep_done = 1; --ph; }
#endif
    }
#undef IN
}

extern "C" void kernel_launch(void* const* d_in, const int* in_sizes, int n_in, void* d_out, int out_size, void* d_ws, size_t ws_size, hipStream_t stream) {
    static int grid = 0;
    if (grid == 0) {
        if (n_in != 24 || in_sizes[0] != M * DM || out_size != M * DM || ws_size < WS_END) {
            fprintf(stderr, "kernel_launch: unexpected shapes (n_in %d, in0 %d, out %d, ws %zu need %zu); nothing launched\n", n_in, n_in > 0 ? in_sizes[0] : -1, out_size, ws_size, (size_t)WS_END);
            grid = -1; return; }
        int dev = 0, cus = 0, per_cu = 0;
        (void)hipGetDevice(&dev);
        (void)hipDeviceGetAttribute(&cus, hipDeviceAttributeMultiprocessorCount, dev);
        if (hipFuncSetAttribute((const void*)fwd_megakernel, hipFuncAttributeMaxDynamicSharedMemorySize, LDS_BYTES) != hipSuccess) { fprintf(stderr, "kernel_launch: hipFuncSetAttribute failed\n"); grid = -1; return; }
        if (hipOccupancyMaxActiveBlocksPerMultiprocessor(&per_cu, (const void*)fwd_megakernel, NTHREADS, LDS_BYTES) != hipSuccess || per_cu < 1) { fprintf(stderr, "kernel_launch: occupancy query gave %d\n", per_cu); per_cu = 1; }
        (void)hipGetLastError();
        grid = cus * per_cu;
    }
    if (grid < 0) return;
    if (hipMemsetAsync((char*)d_ws + WS_CTL, 0, CTL_ZERO_BYTES, stream) != hipSuccess) { fprintf(stderr, "kernel_launch: memset failed\n"); return; }
    Args a{};
    for (int i = 0; i < 24; ++i) a.in[i] = (const float*)d_in[i];
    a.out = (float*)d_out; a.ws = (unsigned char*)d_ws;
    void* kargs[] = {&a};
    hipError_t e = hipLaunchCooperativeKernel((const void*)fwd_megakernel, dim3(grid), dim3(NTHREADS), kargs, LDS_BYTES, stream);
    if (e != hipSuccess) fprintf(stderr, "cooperative launch failed: %s (grid %d)\n", hipGetErrorString(e), grid);
}
```
